# Optimizing an MI355X kernel written in HIP

```python
import math
import jax
import jax.numpy as jnp
from jax import lax
import numpy as np

D_MODEL = 1024
BATCH = 4
SEQ = 4096
DEPTH = 2

D_FF = 2816
D_RNN = 1024
RNN_BLOCKS = 16
RNN_BLOCK_W = D_RNN // RNN_BLOCKS
RNN_CONV_W = 4
RG_LRU_C = 8.0
D_SCONV = 1024
SCONV_W = 3
N_HEADS = 8
N_KV_HEADS = 2
HEAD_DIM = 128
N_IDX_HEADS = 8
IDX_DIM = 64
INDEX_TOPK_MAX = 256
Q_BLOCK = 128
ROPE_THETA = 500000.0
ROPE_FRACTION_DEN = 4
N_BRANCHES = 3
RMS_EPS = 1e-6

kernel_name = "hybrid_rglru_shortconv_dsa_macaron"

IN_SIZES = (D_RNN, D_RNN,
            D_SCONV, D_SCONV, D_SCONV,
            N_HEADS * HEAD_DIM, N_KV_HEADS * HEAD_DIM, N_KV_HEADS * HEAD_DIM,
            N_IDX_HEADS * IDX_DIM, IDX_DIM, N_IDX_HEADS,
            N_BRANCHES * D_MODEL)
D_IN = sum(IN_SIZES)


def rms_norm(x, g):
    xf = x.astype(jnp.float32)
    y = xf * lax.rsqrt(jnp.mean(xf * xf, axis=-1, keepdims=True) + RMS_EPS)
    return (y * g.astype(jnp.float32)).astype(x.dtype)


def swiglu(x, w_gate_up, w_down):
    g, u = jnp.split(x @ w_gate_up, 2, axis=-1)
    return (jax.nn.silu(g) * u) @ w_down


def causal_dwconv(x, w):
    width = w.shape[0]
    s = x.shape[1]
    xp = jnp.pad(x, ((0, 0), (width - 1, 0), (0, 0)))
    return sum(xp[:, k:k + s] * w[k] for k in range(width))


def partial_rope(x, positions):
    dh = x.shape[-1]
    rot = dh // ROPE_FRACTION_DEN
    half = rot // 2
    inv_freq = ROPE_THETA ** (-jnp.arange(0, rot, 2, dtype=jnp.float32) / rot)
    ang = positions.astype(jnp.float32)[..., None] * inv_freq
    cos = jnp.cos(ang)[:, :, None, :]
    sin = jnp.sin(ang)[:, :, None, :]
    xf = x.astype(jnp.float32)
    x1, x2, xp = xf[..., :half], xf[..., half:rot], xf[..., rot:]
    out = jnp.concatenate([x1 * cos - x2 * sin, x2 * cos + x1 * sin, xp], axis=-1)
    return out.astype(x.dtype)


def rg_lru(x, wa, ba, wx, bx, lam):
    b, s, c = x.shape
    xb = x.reshape(b, s, RNN_BLOCKS, RNN_BLOCK_W)
    r = jax.nn.sigmoid(jnp.einsum('bsni,nij->bsnj', xb, wa).reshape(b, s, c) + ba)
    i = jax.nn.sigmoid(jnp.einsum('bsni,nij->bsnj', xb, wx).reshape(b, s, c) + bx)
    log_a = -RG_LRU_C * r.astype(jnp.float32) * jax.nn.softplus(-lam.astype(jnp.float32))
    a = jnp.exp(log_a)
    in_scale = jnp.sqrt(-jnp.expm1(2.0 * log_a))
    u = in_scale * (i * x).astype(jnp.float32)

    def combine(left, right):
        a1, b1 = left
        a2, b2 = right
        return a1 * a2, a2 * b1 + b2

    _, h = lax.associative_scan(combine, (a, u), axis=1)
    return h.astype(x.dtype)


def dsa_attention(q, k, v, q_idx, k_idx, w_idx):
    b, s, h, dh = q.shape
    g = k.shape[2]
    hpg = h // g
    top_k = min(INDEX_TOPK_MAX, s // 4)
    n_blk = s // Q_BLOCK
    key_pos = jnp.arange(s)
    w_scale = (N_IDX_HEADS ** -0.5) * (IDX_DIM ** -0.5)
    attn_scale = dh ** -0.5

    def to_blocks(t):
        t = t.reshape((b, n_blk, Q_BLOCK) + t.shape[2:])
        return jnp.moveaxis(t, 1, 0)

    k_idx_f = k_idx.astype(jnp.float32)

    def one_block(args):
        qb, qib, wb, start = args
        q_pos = start + jnp.arange(Q_BLOCK)
        rel = jax.nn.relu(jnp.einsum('bqhd,bsd->bqhs', qib.astype(jnp.float32), k_idx_f))
        score = jnp.einsum('bqh,bqhs->bqs', wb.astype(jnp.float32) * w_scale, rel)
        causal = key_pos[None, :] <= q_pos[:, None]
        score = jnp.where(causal[None], score, -jnp.inf)
        _, idx = lax.top_k(score, top_k)
        sel_ok = idx <= q_pos[None, :, None]
        kg = jax.vmap(lambda kk, ii: kk[ii])(k, idx)
        vg = jax.vmap(lambda vv, ii: vv[ii])(v, idx)
        qg = qb.reshape(b, Q_BLOCK, g, hpg, dh)
        logits = jnp.einsum('bqgjd,bqkgd->bqgjk', qg, kg).astype(jnp.float32) * attn_scale
        logits = jnp.where(sel_ok[:, :, None, None, :], logits, -jnp.inf)
        p = jax.nn.softmax(logits, axis=-1).astype(vg.dtype)
        o = jnp.einsum('bqgjk,bqkgd->bqgjd', p, vg)
        return o.reshape(b, Q_BLOCK, h * dh)

    starts = jnp.arange(n_blk) * Q_BLOCK
    out = lax.map(one_block, (to_blocks(q), to_blocks(q_idx), to_blocks(w_idx), starts))
    return jnp.moveaxis(out, 0, 1).reshape(b, s, h * dh)


def token_mixing(u, positions, w_in, rnn_conv_w, rnn_conv_b, rnn_gate_a_w, rnn_gate_a_b,
                 rnn_gate_x_w, rnn_gate_x_b, rnn_lambda, rnn_w_out, sconv_w, sconv_w_out,
                 attn_w_out, w_o):
    b, s, _ = u.shape
    proj = u @ w_in
    cuts = []
    acc = 0
    for sz in IN_SIZES[:-1]:
        acc += sz
        cuts.append(acc)
    (rnn_x, rnn_g, c_b, c_c, c_h, q, k, v, qi, ki, wi, gates) = jnp.split(proj, cuts, axis=-1)

    xa = causal_dwconv(rnn_x, rnn_conv_w) + rnn_conv_b
    ha = rg_lru(xa, rnn_gate_a_w, rnn_gate_a_b, rnn_gate_x_w, rnn_gate_x_b, rnn_lambda)
    ya = (ha * jax.nn.gelu(rnn_g)) @ rnn_w_out

    yb = (c_b * causal_dwconv(c_c * c_h, sconv_w)) @ sconv_w_out

    q = partial_rope(q.reshape(b, s, N_HEADS, HEAD_DIM), positions)
    k = partial_rope(k.reshape(b, s, N_KV_HEADS, HEAD_DIM), positions)
    v = v.reshape(b, s, N_KV_HEADS, HEAD_DIM)
    qi = partial_rope(qi.reshape(b, s, N_IDX_HEADS, IDX_DIM), positions)
    ki = partial_rope(ki.reshape(b, s, 1, IDX_DIM), positions)[:, :, 0]
    yc = dsa_attention(q, k, v, qi, ki, wi) @ attn_w_out

    gt = jax.nn.sigmoid(gates.reshape(b, s, N_BRANCHES, D_MODEL))
    merged = gt[:, :, 0] * ya + gt[:, :, 1] * yb + gt[:, :, 2] * yc
    return merged @ w_o


def setup_inputs(seed: int = 0) -> dict:
    key = jax.random.key(seed)
    ks = iter(jax.random.split(key, 32))
    f32 = jnp.float32

    def nrm(shape, fan_in):
        return jax.random.normal(next(ks), shape, f32) * (fan_in ** -0.5)

    def gain(shape):
        return 1.0 + 0.02 * jax.random.normal(next(ks), shape, f32)

    def bias(shape):
        return 0.01 * jax.random.normal(next(ks), shape, f32)

    L = DEPTH
    x = jax.random.normal(next(ks), (BATCH, SEQ, D_MODEL), f32)
    offs = jax.random.randint(next(ks), (BATCH, 1), 0, 1024, dtype=jnp.int32)
    positions = offs + jnp.arange(SEQ, dtype=jnp.int32)[None, :]
    a0 = jax.random.uniform(next(ks), (L, D_RNN), f32, 0.9, 0.999)
    sig = a0 ** (1.0 / RG_LRU_C)
    rnn_lambda = jnp.log(sig) - jnp.log1p(-sig)
    return {
        "x": x,
        "positions": positions,
        "ffn1_norm": gain((L, D_MODEL)),
        "ffn1_w_gate_up": nrm((L, D_MODEL, 2 * D_FF), D_MODEL),
        "ffn1_w_down": nrm((L, D_FF, D_MODEL), D_FF),
        "mix_norm": gain((L, D_MODEL)),
        "w_in": nrm((L, D_MODEL, D_IN), D_MODEL),
        "rnn_conv_w": nrm((L, RNN_CONV_W, D_RNN), RNN_CONV_W),
        "rnn_conv_b": bias((L, D_RNN)),
        "rnn_gate_a_w": nrm((L, RNN_BLOCKS, RNN_BLOCK_W, RNN_BLOCK_W), RNN_BLOCK_W),
        "rnn_gate_a_b": bias((L, D_RNN)),
        "rnn_gate_x_w": nrm((L, RNN_BLOCKS, RNN_BLOCK_W, RNN_BLOCK_W), RNN_BLOCK_W),
        "rnn_gate_x_b": bias((L, D_RNN)),
        "rnn_lambda": rnn_lambda,
        "rnn_w_out": nrm((L, D_RNN, D_MODEL), D_RNN),
        "sconv_w": nrm((L, SCONV_W, D_SCONV), SCONV_W),
        "sconv_w_out": nrm((L, D_SCONV, D_MODEL), D_SCONV),
        "attn_w_out": nrm((L, N_HEADS * HEAD_DIM, D_MODEL), N_HEADS * HEAD_DIM),
        "w_o": nrm((L, D_MODEL, D_MODEL), D_MODEL),
        "ffn2_norm": gain((L, D_MODEL)),
        "ffn2_w_gate_up": nrm((L, D_MODEL, 2 * D_FF), D_MODEL),
        "ffn2_w_down": nrm((L, D_FF, D_MODEL), D_FF),
        "final_norm": gain((D_MODEL,)),
    }


def reference(x, positions, ffn1_norm, ffn1_w_gate_up, ffn1_w_down, mix_norm, w_in,
              rnn_conv_w, rnn_conv_b, rnn_gate_a_w, rnn_gate_a_b, rnn_gate_x_w, rnn_gate_x_b,
              rnn_lambda, rnn_w_out, sconv_w, sconv_w_out, attn_w_out, w_o,
              ffn2_norm, ffn2_w_gate_up, ffn2_w_down, final_norm):
    for l in range(DEPTH):
        x = x + 0.5 * swiglu(rms_norm(x, ffn1_norm[l]), ffn1_w_gate_up[l], ffn1_w_down[l])
        x = x + token_mixing(rms_norm(x, mix_norm[l]), positions, w_in[l],
                             rnn_conv_w[l], rnn_conv_b[l], rnn_gate_a_w[l], rnn_gate_a_b[l],
                             rnn_gate_x_w[l], rnn_gate_x_b[l], rnn_lambda[l], rnn_w_out[l],
                             sconv_w[l], sconv_w_out[l], attn_w_out[l], w_o[l])
        x = x + 0.5 * swiglu(rms_norm(x, ffn2_norm[l]), ffn2_w_gate_up[l], ffn2_w_down[l])
    return rms_norm(x, final_norm)
```

```cpp
#include <hip/hip_runtime.h>
#include <hip/hip_cooperative_groups.h>
namespace cg = cooperative_groups;

#define LAS __attribute__((address_space(3)))
typedef unsigned short bf16_t;
typedef short bf16x8 __attribute__((ext_vector_type(8)));
typedef short s16x4 __attribute__((ext_vector_type(4)));
typedef float f32x4 __attribute__((ext_vector_type(4)));
typedef unsigned u32x4 __attribute__((ext_vector_type(4)));
typedef unsigned u32x2 __attribute__((ext_vector_type(2)));
typedef float f32x2 __attribute__((ext_vector_type(2)));

constexpr int T = 16384, S = 4096, NB = 4, DM = 1024, DFF = 2816;
constexpr int LC = 256, NCH = S / LC;
constexpr size_t DYN_LDS = 147456 + 256;

constexpr size_t OFF_WGU1 = 0;
constexpr size_t OFF_WD1 = OFF_WGU1 + (size_t)5632 * 1024 * 2;
constexpr size_t OFF_WIN = OFF_WD1 + (size_t)1024 * 2816 * 2;
constexpr size_t OFF_WOUT3 = OFF_WIN + (size_t)10496 * 1024 * 2;
constexpr size_t OFF_WO = OFF_WOUT3 + (size_t)3 * 1024 * 1024 * 2;
constexpr size_t OFF_WGU2 = OFF_WO + (size_t)1024 * 1024 * 2;
constexpr size_t OFF_WD2 = OFF_WGU2 + (size_t)5632 * 1024 * 2;
constexpr size_t OFF_WRG = OFF_WD2 + (size_t)1024 * 2816 * 2;
constexpr size_t OFF_XB = OFF_WRG + (size_t)16 * 128 * 64 * 2;
constexpr size_t OFF_ROWSS = OFF_XB + (size_t)T * 1024 * 2;
constexpr size_t OFF_CS128 = OFF_ROWSS + (size_t)7 * T * 16 * 4;
constexpr size_t OFF_CS64 = OFF_CS128 + (size_t)T * 16 * 8;
constexpr size_t OFF_RS = OFF_CS64 + (size_t)T * 8 * 8;
constexpr size_t OFF_BIG = OFF_RS + (size_t)NB * NCH * 1024 * 2 * 4;
constexpr size_t OFF_H = OFF_BIG;
constexpr size_t OFF_RNNX = OFF_BIG;
constexpr size_t OFF_INB = OFF_RNNX + (size_t)T * 1024 * 2;
constexpr size_t OFF_CCH = OFF_INB + (size_t)2 * T * 1024 * 2;
constexpr size_t OFF_Q = OFF_CCH + (size_t)T * 1024 * 2;
constexpr size_t OFF_KB = OFF_Q + (size_t)T * 1024 * 2;
constexpr size_t OFF_VB = OFF_KB + (size_t)T * 256 * 2;
constexpr size_t OFF_QI = OFF_VB + (size_t)T * 256 * 2;
constexpr size_t OFF_KI = OFF_QI + (size_t)T * 512 * 2;
constexpr size_t OFF_WI = OFF_KI + (size_t)T * 64 * 2;
constexpr size_t OFF_BAR = OFF_WI + (size_t)T * 8 * 4;
constexpr size_t WS_NEED = OFF_BAR + 16384;

struct P {
    const float* x; const int* pos;
    const float* ffn1_norm; const float* ffn1_gu; const float* ffn1_dn; const float* mix_norm; const float* w_in;
    const float* rnn_conv_w; const float* rnn_conv_b; const float* ga_w; const float* ga_b; const float* gx_w; const float* gx_b; const float* lam;
    const float* rnn_w_out; const float* sconv_w; const float* sconv_w_out; const float* attn_w_out; const float* w_o;
    const float* ffn2_norm; const float* ffn2_gu; const float* ffn2_dn; const float* final_norm;
    float* out; unsigned char* ws;
};

__device__ __forceinline__ unsigned pk_bf16(float lo, float hi) { unsigned r; asm("v_cvt_pk_bf16_f32 %0, %1, %2" : "=v"(r) : "v"(lo), "v"(hi)); return r; }
__device__ __forceinline__ bf16_t f2bf(float f) { return (bf16_t)(pk_bf16(f, 0.f) & 0xffffu); }
__device__ __forceinline__ float bf_lo(unsigned u) { return __uint_as_float(u << 16); }
__device__ __forceinline__ float bf_hi(unsigned u) { return __uint_as_float(u & 0xffff0000u); }
__device__ __forceinline__ float fast_rcp(float x) { return __builtin_amdgcn_rcpf(x); }
__device__ __forceinline__ float sigmoid_f(float x) { return fast_rcp(1.0f + __expf(-x)); }
__device__ __forceinline__ float silu_f(float x) { return x * sigmoid_f(x); }
__device__ __forceinline__ float gelu_tanh_f(float x) { return x * sigmoid_f(1.5957691216f * (x + 0.044715f * x * x * x)); }
__device__ __forceinline__ float rinv_of(const float* rowss, int row) {
    const f32x4* q = (const f32x4*)(rowss + ((size_t)(row >> 8) * 4 * 256 + (row & 255)) * 4); const f32x4 a = q[0], b = q[256], c = q[512], d = q[768];
    const float s = ((a[0] + a[1]) + (a[2] + a[3])) + ((b[0] + b[1]) + (b[2] + b[3])) + ((c[0] + c[1]) + (c[2] + c[3])) + ((d[0] + d[1]) + (d[2] + d[3]));
    return rsqrtf(s * (1.0f / 1024.0f) + 1e-6f); }
__device__ __forceinline__ int lane_id() { unsigned m = ~0u; asm volatile("" : "+s"(m)); return (int)__builtin_amdgcn_mbcnt_hi(m, __builtin_amdgcn_mbcnt_lo(m, 0u)); }
__device__ __forceinline__ float xshfl_f(float v, int src) { return __int_as_float(__builtin_amdgcn_ds_bpermute(src << 2, __float_as_int(v))); }
__device__ __forceinline__ unsigned xshfl_u(unsigned v, int src) { return (unsigned)__builtin_amdgcn_ds_bpermute(src << 2, (int)v); }
#define GET_TID(wv) ({ int w_ = (wv); asm volatile("" : "+s"(w_)); int t_ = w_ * 64 + lane_id(); asm volatile("" : "+v"(t_)); t_; })
__device__ __forceinline__ void load_rinv8(const float* rowss, int row0, int fq, int ln, float (&rv)[8]) {
    f32x4 p[8];
#pragma unroll
    for (int i = 0; i < 8; ++i) { const int row = row0 + (i >> 2) * 128 + (i & 3) * 16; p[i] = *(const f32x4*)(rowss + (((size_t)(row >> 8) * 4 + fq) * 256 + (row & 255)) * 4); }
#pragma unroll
    for (int i = 0; i < 8; ++i) { float s = (p[i][0] + p[i][1]) + (p[i][2] + p[i][3]); s += xshfl_f(s, ln ^ 16); s += xshfl_f(s, ln ^ 32); rv[i] = rsqrtf(s * (1.0f / 1024.0f) + 1e-6f); }
}
#define LDS_FENCE() asm volatile("s_waitcnt lgkmcnt(0)" ::: "memory")

constexpr int BM = 256, BK = 64, HALF = 128, HTB = HALF * BK * 2, NXCD = 8, WGM = 8;
__device__ __forceinline__ int lds_byte(int r, int c) { const int st = (r >> 4) * 2 + (c >> 5), rr = r & 15, cc = c & 31, ob = rr * 64 + cc * 2; return st * 1024 + (ob ^ (((ob >> 9) & 1) << 5)); }
__device__ __forceinline__ void stage_rc(int b, int& R, int& C) { const int st = b / 1024, sb = b % 1024, swz = sb ^ (((sb >> 9) & 1) << 5); R = (st >> 1) * 16 + swz / 64; C = (st & 1) * 32 + (swz % 64) / 2; }
__device__ __forceinline__ int perm32(int rho) { const int n = rho >> 4, i = rho & 15; return 8 * (i >> 2) + 4 * n + (i & 3); }

struct Unit { const char* A; const char* B; int pm, pn, kind; };

struct TileOrder {
    int nM, nN, nwg, G, c;
    __device__ void init(int M, int N, int G_, int c_) { nM = M / BM; nN = N / BM; nwg = nM * nN; G = G_; c = c_; }
    __device__ bool tile(int i, int& pm, int& pn) const {
        const long L = (long)i * G + c; if (L >= nwg) return false;
        int wgid = (int)L; { const int q = nwg / NXCD, r = nwg % NXCD, xcd = wgid % NXCD, off = wgid / NXCD; wgid = (xcd < r ? xcd * (q + 1) : r * (q + 1) + (xcd - r) * q) + off; }
        const int nig = WGM * nN, gid = wgid / nig, fm = gid * WGM, gsz = (nM - fm) < WGM ? (nM - fm) : WGM;
        pm = fm + ((wgid % nig) % gsz); pn = (wgid % nig) / gsz; return true;
    }
};
struct PlainOrder {
    TileOrder to; const char* A; const char* B; size_t tstep;
    __device__ bool next(int i, Unit& u) const { int pm, pn; if (!to.tile(i, pm, pn)) return false; u.pm = pm; u.pn = pn; u.kind = 0; u.A = A + (size_t)pm * tstep; u.B = B + (size_t)pn * tstep; return true; }
};
struct Out3Order {
    TileOrder to; const char* xb; const char* wing; const char* inb; const char* inc; const char* wout;
    __device__ bool next(int i, Unit& u) const {
        const int ti = i / 6, sub = i - ti * 6, b = sub >> 1; int pm, pn; if (!to.tile(ti, pm, pn)) return false;
        const size_t tstep = (size_t)256 * 1024 * 2; u.pm = pm; u.pn = pn;
        if ((sub & 1) == 0) { u.kind = 0; u.A = xb + (size_t)pm * tstep; u.B = wing + (size_t)(b * 4 + pn) * tstep; }
        else { u.kind = 1 + b; u.A = (b < 2 ? inb + (size_t)(b * 64 + pm) * tstep : inc + (size_t)pm * tstep); u.B = wout + (size_t)(b * 4 + pn) * tstep; }
        return true;
    }
};

template <class Epi, class Sched>
__device__ __forceinline__ void gemm_phase(const int wv, LAS unsigned char* lds, const int K, const Sched& S_, const Epi& E) {
    const int tid = GET_TID(wv);
    const int wid = __builtin_amdgcn_readfirstlane(tid >> 6), lane = tid & 63, wr = wid >> 2, wc = wid & 3, fr = lane & 15, fq = lane >> 4;
    const int nt = K / BK;
    unsigned voffA[2], voffB[2];
#pragma unroll
    for (int i = 0; i < 2; ++i) { int R, C; stage_rc(tid * 16 + i * 8192, R, C); const int Rb = Epi::PERM ? ((R & ~31) + perm32(R & 31)) : R;
        voffA[i] = (unsigned)(R * K + C) * 2u; voffB[i] = (unsigned)(Rb * K + C) * 2u; }
    const size_t kstep = (size_t)(BK * 2);
    const size_t hstep = (size_t)HALF * K * 2;
    const unsigned ldsw = (unsigned)wid * 1024u;
    const int aoff = lds_byte(wr * 64 + fr, fq * 8), boff = lds_byte(wc * 32 + fr, fq * 8);
#define G_SA(b, h) (((b) * 2 + (h)) * HTB)
#define G_SB(b, h) ((4 + (b) * 2 + (h)) * HTB)
#define G_STAGE(bufoff, gbase, voff) do { _Pragma("unroll") for (int _i = 0; _i < 2; ++_i) \
        __builtin_amdgcn_global_load_lds((const unsigned*)((const char*)(gbase) + (voff)[_i]), (LAS unsigned*)(lds + (bufoff) + ldsw + _i * 8192), 16, 0, 0); } while (0)
#define G_LDA(dst, b, h) do { _Pragma("unroll") for (int m = 0; m < 4; ++m) _Pragma("unroll") for (int k = 0; k < 2; ++k) dst[m][k] = *(const LAS bf16x8*)(lds + G_SA(b, h) + aoff + m * 2048 + k * 1024); } while (0)
#define G_LDB(dst, b, h) do { _Pragma("unroll") for (int n = 0; n < 2; ++n) _Pragma("unroll") for (int k = 0; k < 2; ++k) dst[n][k] = *(const LAS bf16x8*)(lds + G_SB(b, h) + boff + n * 2048 + k * 1024); } while (0)
#define G_MMA(ai, bj, At, Bt) do { __builtin_amdgcn_s_setprio(1); _Pragma("unroll") for (int m = 0; m < 4; ++m) _Pragma("unroll") for (int n = 0; n < 2; ++n) _Pragma("unroll") for (int k = 0; k < 2; ++k) \
        acc[ai][bj][m][n] = __builtin_amdgcn_mfma_f32_16x16x32_bf16(Bt[n][k], At[m][k], acc[ai][bj][m][n], 0, 0, 0); __builtin_amdgcn_s_setprio(0); } while (0)
#define G_WAIT_V(n) asm volatile("s_waitcnt vmcnt(" #n ")" ::: "memory")
#define G_WAIT_L(n) asm volatile("s_waitcnt lgkmcnt(" #n ")" ::: "memory")
#define G_BAR __builtin_amdgcn_s_barrier()
#define G_SCHED __builtin_amdgcn_sched_barrier(0)
    Unit cur, nxt; int ui = 0;
    if (!S_.next(0, cur)) return;
    f32x4 acc[2][2][4][2];
#pragma unroll
    for (int a = 0; a < 2; ++a)
#pragma unroll
        for (int b = 0; b < 2; ++b)
#pragma unroll
            for (int m = 0; m < 4; ++m)
#pragma unroll
                for (int n = 0; n < 2; ++n) acc[a][b][m][n] = (f32x4){0.f, 0.f, 0.f, 0.f};
    bf16x8 At[4][2], B0[2][2], B1[2][2];
    const char* cA = cur.A; const char* cB = cur.B;
    G_STAGE(G_SB(0, 0), cB, voffB); G_STAGE(G_SA(0, 0), cA, voffA); G_STAGE(G_SB(0, 1), cB + hstep, voffB); G_STAGE(G_SA(0, 1), cA + hstep, voffA);
    if (wr == 1) G_BAR;
    G_WAIT_V(4); G_BAR;
    G_STAGE(G_SB(1, 0), cB + kstep, voffB); G_STAGE(G_SA(1, 0), cA + kstep, voffA); G_STAGE(G_SB(1, 1), cB + hstep + kstep, voffB);
    G_WAIT_V(6); G_BAR;
    for (;;) {
        const bool has_next = S_.next(ui + 1, nxt);
        const char* nA = has_next ? nxt.A : cA; const char* nB = has_next ? nxt.B : cB;
        for (int t = 0; t < nt; t += 2) {
            const bool last = (t == nt - 2);
            const char* a1 = cA + (size_t)(t + 1) * kstep;
            const char* a2 = last ? nA : cA + (size_t)(t + 2) * kstep; const char* b2 = last ? nB : cB + (size_t)(t + 2) * kstep;
            const char* a3 = a2 + kstep; const char* b3 = b2 + kstep;
            G_LDB(B0, 0, 0); G_SCHED; G_LDA(At, 0, 0); G_STAGE(G_SA(1, 1), a1 + hstep, voffA);
            G_WAIT_L(8); G_BAR; G_WAIT_L(0); G_MMA(0, 0, At, B0); G_BAR; G_SCHED;
            G_LDB(B1, 0, 1); G_STAGE(G_SB(0, 0), b2, voffB);
            G_BAR; G_WAIT_L(0); G_MMA(0, 1, At, B1); G_BAR;
            G_LDA(At, 0, 1); G_STAGE(G_SA(0, 0), a2, voffA);
            G_BAR; G_WAIT_L(0); G_MMA(1, 0, At, B0); G_BAR; G_SCHED;
            G_STAGE(G_SB(0, 1), b2 + hstep, voffB);
            G_WAIT_V(6); G_BAR; G_MMA(1, 1, At, B1); G_BAR;
            G_LDB(B0, 1, 0); G_SCHED; G_LDA(At, 1, 0); G_STAGE(G_SA(0, 1), a2 + hstep, voffA);
            G_WAIT_L(8); G_BAR; G_WAIT_L(0); G_MMA(0, 0, At, B0); G_BAR; G_SCHED;
            G_LDB(B1, 1, 1); G_STAGE(G_SB(1, 0), b3, voffB);
            G_BAR; G_WAIT_L(0); G_MMA(0, 1, At, B1); G_BAR;
            G_LDA(At, 1, 1); G_STAGE(G_SA(1, 0), a3, voffA);
            G_BAR; G_WAIT_L(0); G_MMA(1, 0, At, B0); G_BAR; G_SCHED;
            G_STAGE(G_SB(1, 1), b3 + hstep, voffB);
            G_WAIT_V(6); G_BAR; G_MMA(1, 1, At, B1); G_BAR;
        }
        E(acc, cur, wr, wc, fr, fq);
        if (!has_next) break;
#pragma unroll
        for (int a = 0; a < 2; ++a)
#pragma unroll
            for (int b = 0; b < 2; ++b)
#pragma unroll
                for (int m = 0; m < 4; ++m)
#pragma unroll
                    for (int n = 0; n < 2; ++n) acc[a][b][m][n] = (f32x4){0.f, 0.f, 0.f, 0.f};
        cur = nxt; cA = nA; cB = nB; ++ui;
    }
    G_WAIT_V(0);
    if (wr == 0) G_BAR;
    G_BAR;
}

typedef f32x4 Acc[2][2][4][2];

struct EpiFfnUp {
    static constexpr bool PERM = true;
    bf16_t* H; const float* rowss;
    __device__ __forceinline__ void operator()(const Acc& acc, const Unit& u, int wr, int wc, int fr, int fq) const {
        int row0 = u.pm * BM + wr * 64 + fr; asm volatile("" : "+v"(row0)); const int col0 = u.pn * 128 + wc * 32 + 8 * fq;
        float rv[8]; load_rinv8(rowss, row0, fq, fq * 16 + fr, rv);
#pragma unroll
        for (int ai = 0; ai < 2; ++ai)
#pragma unroll
            for (int m = 0; m < 4; ++m) {
                const int row = row0 + ai * HALF + m * 16; const float r = rv[ai * 4 + m];
                float o[8];
#pragma unroll
                for (int n = 0; n < 2; ++n)
#pragma unroll
                    for (int j = 0; j < 4; ++j) o[n * 4 + j] = silu_f(acc[ai][0][m][n][j] * r) * (acc[ai][1][m][n][j] * r);
                u32x4 pk = {pk_bf16(o[0], o[1]), pk_bf16(o[2], o[3]), pk_bf16(o[4], o[5]), pk_bf16(o[6], o[7])};
                *(u32x4*)(H + (size_t)row * DFF + col0) = pk;
            }
    }
};

struct EpiResid {
    static constexpr bool PERM = false;
    const float* xin; float* xout; bf16_t* xb; float* rowss_next; float scale;
    __device__ __forceinline__ void operator()(const Acc& acc, const Unit& u, int wr, int wc, int fr, int fq) const {
        int row0 = u.pm * BM + wr * 64 + fr; asm volatile("" : "+v"(row0)); const int col0 = u.pn * BM + wc * 32 + 4 * fq; const int ln = fq * 16 + fr;
#pragma unroll
        for (int ai = 0; ai < 2; ++ai) {
            f32x4 xo[4][2][2];
#pragma unroll
            for (int m = 0; m < 4; ++m)
#pragma unroll
                for (int bj = 0; bj < 2; ++bj)
#pragma unroll
                    for (int n = 0; n < 2; ++n) xo[m][bj][n] = *(const f32x4*)(xin + (size_t)(row0 + ai * HALF + m * 16) * DM + col0 + bj * HALF + n * 16);
#pragma unroll
            for (int m = 0; m < 4; ++m) { const int row = row0 + ai * HALF + m * 16; float ss = 0.f;
#pragma unroll
                for (int bj = 0; bj < 2; ++bj)
#pragma unroll
                    for (int n = 0; n < 2; ++n) { const size_t o = (size_t)row * DM + col0 + bj * HALF + n * 16;
                        const f32x4 v = xo[m][bj][n] + acc[ai][bj][m][n] * scale;
                        *(f32x4*)(xout + o) = v; ss += v[0] * v[0] + v[1] * v[1] + v[2] * v[2] + v[3] * v[3];
                        *(u32x2*)(xb + o) = (u32x2){pk_bf16(v[0], v[1]), pk_bf16(v[2], v[3])}; }
                ss += xshfl_f(ss, ln ^ 16); ss += xshfl_f(ss, ln ^ 32);
                if (fq == 0) rowss_next[(((size_t)(row >> 8) * 4 + u.pn) * 256 + (row & 255)) * 4 + wc] = ss; }
        }
    }
};

struct EpiWin {
    static constexpr bool PERM = false;
    const float* rowss; unsigned char* ws;
    __device__ __forceinline__ void operator()(const Acc& acc, const Unit& u, int wr, int wc, int fr, int fq) const {
        const int pn = u.pn; int row0 = u.pm * BM + wr * 64 + fr; asm volatile("" : "+v"(row0)); const int ctl = wc * 32 + 4 * fq;
        float rv[8]; load_rinv8(rowss, row0, fq, fq * 16 + fr, rv);
        bf16_t* const RNNX = (bf16_t*)(ws + OFF_RNNX); bf16_t* const INB = (bf16_t*)(ws + OFF_INB); bf16_t* const CCH = (bf16_t*)(ws + OFF_CCH);
        bf16_t* const KB = (bf16_t*)(ws + OFF_KB); bf16_t* const VB = (bf16_t*)(ws + OFF_VB); bf16_t* const QI = (bf16_t*)(ws + OFF_QI); bf16_t* const KI = (bf16_t*)(ws + OFF_KI);
        float* const WI = (float*)(ws + OFF_WI);
        const float* const CS128 = (const float*)(ws + OFF_CS128); const float* const CS64 = (const float*)(ws + OFF_CS64);
#pragma unroll
        for (int ai = 0; ai < 2; ++ai)
#pragma unroll
            for (int m = 0; m < 4; ++m) {
                const int row = row0 + ai * HALF + m * 16; const float r = rv[ai * 4 + m];
                if (pn >= 12 && pn < 20) {
#pragma unroll
                    for (int n = 0; n < 2; ++n) { const f32x4 a = acc[ai][0][m][n] * r, b = acc[ai][1][m][n] * r; const f32x4 v = a * b;
                        *(u32x2*)(CCH + (size_t)row * 1024 + (pn - 12) * 128 + ctl + 16 * n) = (u32x2){pk_bf16(v[0], v[1]), pk_bf16(v[2], v[3])}; }
                } else {
#pragma unroll
                    for (int bj = 0; bj < 2; ++bj) {
                        f32x4 v0 = acc[ai][bj][m][0] * r, v1 = acc[ai][bj][m][1] * r; const int ct = bj * HALF + ctl;
                        bf16_t* dst = nullptr;
                        if (pn < 4) dst = RNNX + (size_t)row * 1024 + pn * 256 + ct;
                        else if (pn < 8) { dst = INB + (size_t)row * 1024 + (pn - 4) * 256 + ct;
#pragma unroll
                            for (int j = 0; j < 4; ++j) { v0[j] = gelu_tanh_f(v0[j]); v1[j] = gelu_tanh_f(v1[j]); } }
                        else if (pn < 12) dst = INB + (size_t)T * 1024 + (size_t)row * 1024 + (pn - 8) * 256 + ct;
                        else if (pn < 25) {
                            if (wc == 0) { const f32x4* cs = (const f32x4*)(CS128 + (size_t)row * 32 + 8 * fq);
                                const f32x4 c01 = cs[0], c23 = cs[1]; const float cv[4] = {c01[0], c01[2], c23[0], c23[2]}, sv[4] = {c01[1], c01[3], c23[1], c23[3]};
#pragma unroll
                                for (int j = 0; j < 4; ++j) { const float x1 = v0[j], x2 = v1[j]; v0[j] = x1 * cv[j] - x2 * sv[j]; v1[j] = x2 * cv[j] + x1 * sv[j]; } }
                            if (pn < 24) { v0 *= 0.08838834764831845f; v1 *= 0.08838834764831845f; dst = (bf16_t*)(ws + OFF_Q) + (size_t)row * 1024 + (pn - 20) * 256 + ct; }
                            else dst = KB + (size_t)row * 256 + ct;
                        }
                        else if (pn == 25) dst = VB + (size_t)row * 256 + ct;
                        else if (pn < 28 || (bj == 0 && wc < 2)) {
                            if ((wc & 1) == 0 && fq < 2) { const f32x4* cs = (const f32x4*)(CS64 + (size_t)row * 16 + 8 * fq);
                                const f32x4 c01 = cs[0], c23 = cs[1]; const float cv[4] = {c01[0], c01[2], c23[0], c23[2]}, sv[4] = {c01[1], c01[3], c23[1], c23[3]};
#pragma unroll
                                for (int j = 0; j < 4; ++j) { const float x1 = v0[j], x2 = v1[j]; v0[j] = x1 * cv[j] - x2 * sv[j]; v1[j] = x2 * cv[j] + x1 * sv[j]; } }
                            dst = (pn < 28) ? QI + (size_t)row * 512 + (pn - 26) * 256 + ct : nullptr;
                            if (pn == 28) {
                                bf16_t* kd = KI + ((size_t)(row >> 4) * 8) * 128 + (row & 15) * 8;
                                *(u32x2*)(kd + (ct >> 3) * 128 + (ct & 7)) = (u32x2){pk_bf16(v0[0], v0[1]), pk_bf16(v0[2], v0[3])};
                                *(u32x2*)(kd + ((ct + 16) >> 3) * 128 + ((ct + 16) & 7)) = (u32x2){pk_bf16(v1[0], v1[1]), pk_bf16(v1[2], v1[3])}; }
                        }
                        else if (bj == 0 && wc == 2 && fq < 2) *(f32x4*)(WI + (size_t)row * 8 + 4 * fq) = v0;
                        if (dst) { *(u32x2*)dst = (u32x2){pk_bf16(v0[0], v0[1]), pk_bf16(v0[2], v0[3])}; *(u32x2*)(dst + 16) = (u32x2){pk_bf16(v1[0], v1[1]), pk_bf16(v1[2], v1[3])}; }
                    }
                }
            }
    }
};

struct EpiOut3 {
    static constexpr bool PERM = true;
    const float* rowss; bf16_t* G; float* M;
    __device__ __forceinline__ void operator()(const Acc& acc, const Unit& u, int wr, int wc, int fr, int fq) const {
        int row0 = u.pm * BM + wr * 64 + fr; asm volatile("" : "+v"(row0)); const int col0 = u.pn * BM + wc * 32 + 8 * fq; const int kind = u.kind;
#pragma unroll
        for (int ai = 0; ai < 2; ++ai)
#pragma unroll
            for (int m = 0; m < 4; ++m) {
                const int row = row0 + ai * HALF + m * 16;
                if (kind == 0) { const float r = rinv_of(rowss, row);
#pragma unroll
                    for (int bj = 0; bj < 2; ++bj) { const f32x4 a = acc[ai][bj][m][0] * r, b = acc[ai][bj][m][1] * r;
                        u32x4 pk = {pk_bf16(sigmoid_f(a[0]), sigmoid_f(a[1])), pk_bf16(sigmoid_f(a[2]), sigmoid_f(a[3])), pk_bf16(sigmoid_f(b[0]), sigmoid_f(b[1])), pk_bf16(sigmoid_f(b[2]), sigmoid_f(b[3]))};
                        *(u32x4*)(G + (size_t)row * DM + col0 + bj * HALF) = pk; }
                } else {
#pragma unroll
                    for (int bj = 0; bj < 2; ++bj) { const size_t o = (size_t)row * DM + col0 + bj * HALF;
                        const u32x4 g = *(const u32x4*)(G + o);
                        f32x4 a = acc[ai][bj][m][0], b = acc[ai][bj][m][1];
                        a[0] *= bf_lo(g[0]); a[1] *= bf_hi(g[0]); a[2] *= bf_lo(g[1]); a[3] *= bf_hi(g[1]);
                        b[0] *= bf_lo(g[2]); b[1] *= bf_hi(g[2]); b[2] *= bf_lo(g[3]); b[3] *= bf_hi(g[3]);
                        if (kind > 1) { a += *(const f32x4*)(M + o); b += *(const f32x4*)(M + o + 4); }
                        if (kind < 3) { *(f32x4*)(M + o) = a; *(f32x4*)(M + o + 4) = b; }
                        else { u32x4 pk = {pk_bf16(a[0], a[1]), pk_bf16(a[2], a[3]), pk_bf16(b[0], b[1]), pk_bf16(b[2], b[3])}; *(u32x4*)(G + o) = pk; }
                    }
                }
            }
    }
};

__device__ __forceinline__ int map_col(int kind, int c) {
    if (kind == 0) return c;
    if (kind == 1) { const int pn = c >> 8, bj = (c >> 7) & 1, i = c & 127; return (bj ? 2816 : 0) + pn * 128 + i; }
    if (c < 3072) return c;
    if (c < 5120) { const int cc = c - 3072, tt = cc >> 8, bj = (cc >> 7) & 1, i = cc & 127; return (bj ? 4096 : 3072) + tt * 128 + i; }
    if (c < 6656) return c;
    if (c < 7232) { const int cc = c - 6656, hd = cc >> 6, p = cc & 63; const int d = (p >= 8 && p < 16) ? p + 8 : ((p >= 16 && p < 24) ? p - 8 : p); return 6656 + hd * 64 + d; }
    if (c < 7240) return c;
    if (c < 7424) return -1;
    return 7240 + (c - 7424);
}
struct Job { const float* src; bf16_t* dst; const float* gain; int K, Nsrc, Nlog, kind; };
__device__ __forceinline__ Job get_job(const P& p, int l, int j) {
    Job jb; unsigned char* ws = p.ws;
    switch (j) {
    case 0: jb = {p.ffn1_gu + (size_t)l * 1024 * 5632, (bf16_t*)(ws + OFF_WGU1), p.ffn1_norm + l * 1024, 1024, 5632, 5632, 1}; break;
    case 1: jb = {p.ffn1_dn + (size_t)l * 2816 * 1024, (bf16_t*)(ws + OFF_WD1), nullptr, 2816, 1024, 1024, 0}; break;
    case 2: jb = {p.w_in + (size_t)l * 1024 * 10312, (bf16_t*)(ws + OFF_WIN), p.mix_norm + l * 1024, 1024, 10312, 10496, 2}; break;
    case 3: jb = {p.rnn_w_out + (size_t)l * 1024 * 1024, (bf16_t*)(ws + OFF_WOUT3), nullptr, 1024, 1024, 1024, 0}; break;
    case 4: jb = {p.sconv_w_out + (size_t)l * 1024 * 1024, (bf16_t*)(ws + OFF_WOUT3 + (size_t)2 * 1024 * 1024), nullptr, 1024, 1024, 1024, 0}; break;
    case 5: jb = {p.attn_w_out + (size_t)l * 1024 * 1024, (bf16_t*)(ws + OFF_WOUT3 + (size_t)4 * 1024 * 1024), nullptr, 1024, 1024, 1024, 0}; break;
    case 6: jb = {p.w_o + (size_t)l * 1024 * 1024, (bf16_t*)(ws + OFF_WO), nullptr, 1024, 1024, 1024, 0}; break;
    case 7: jb = {p.ffn2_gu + (size_t)l * 1024 * 5632, (bf16_t*)(ws + OFF_WGU2), p.ffn2_norm + l * 1024, 1024, 5632, 5632, 1}; break;
    default: jb = {p.ffn2_dn + (size_t)l * 2816 * 1024, (bf16_t*)(ws + OFF_WD2), nullptr, 2816, 1024, 1024, 0}; break;
    }
    return jb;
}

__device__ __forceinline__ void prep_phase(const int wv, const P& p, int l, unsigned char* sm, const unsigned jobmask, const int wrank, const int wcount, const bool extras) {
    const int tid = GET_TID(wv); const int lane = tid & 63;
    bf16_t* tl = (bf16_t*)sm;
    int ntile[9]; int total = 0;
#pragma unroll
    for (int j = 0; j < 9; ++j) { const Job jb = get_job(p, l, j); ntile[j] = ((jobmask >> j) & 1u) ? (jb.Nlog / 64) * (jb.K / 64) : 0; total += ntile[j]; }
    for (int tix = wrank; tix < total; tix += 2 * wcount) {
        const int cl = tid & 63, kr = tid >> 6;
        Job jbs[2]; int c0s[2], k0s[2]; float v[2][8]; bool ok[2];
#pragma unroll
        for (int h = 0; h < 2; ++h) { const int tt = tix + h * wcount; ok[h] = tt < total; int jj = 0, rem = ok[h] ? tt : tix;
#pragma unroll
            for (int q = 0; q < 8; ++q) { if (jj == q && rem >= ntile[q]) { rem -= ntile[q]; jj = q + 1; } }
            jbs[h] = get_job(p, l, jj); const int nct = jbs[h].Nlog / 64; c0s[h] = 64 * (rem % nct); k0s[h] = 64 * (rem / nct);
            const int s = map_col(jbs[h].kind, c0s[h] + cl);
#pragma unroll
            for (int i = 0; i < 8; ++i) { const int k = k0s[h] + 8 * kr + i; v[h][i] = (s >= 0) ? jbs[h].src[(size_t)k * jbs[h].Nsrc + s] : 0.f; }
            if (jbs[h].gain) {
#pragma unroll
                for (int i = 0; i < 8; ++i) v[h][i] *= jbs[h].gain[k0s[h] + 8 * kr + i]; } }
#pragma unroll
        for (int h = 0; h < 2; ++h) *(u32x4*)(tl + h * 64 * 72 + cl * 72 + 8 * kr) = (u32x4){pk_bf16(v[h][0], v[h][1]), pk_bf16(v[h][2], v[h][3]), pk_bf16(v[h][4], v[h][5]), pk_bf16(v[h][6], v[h][7])};
        __syncthreads();
#pragma unroll
        for (int h = 0; h < 2; ++h) if (ok[h]) { const int rw = tid >> 3, kk = (tid & 7) * 8; const u32x4 d = *(const u32x4*)(tl + h * 64 * 72 + rw * 72 + kk);
            *(u32x4*)(jbs[h].dst + (size_t)(c0s[h] + rw) * jbs[h].K + k0s[h] + kk) = d; }
        __syncthreads();
    }
    if (extras) { bf16_t* wrg = (bf16_t*)(p.ws + OFF_WRG); const float* wa = p.ga_w + (size_t)l * 16 * 64 * 64; const float* wx = p.gx_w + (size_t)l * 16 * 64 * 64;
      for (int e = blockIdx.x * 512 + tid; e < 16 * 128 * 64; e += gridDim.x * 512) { const int i = e & 63, jp = (e >> 6) & 127, n = e >> 13;
          const float v = (jp < 64 ? wa : wx)[(size_t)n * 4096 + i * 64 + (jp & 63)]; wrg[e] = f2bf(v); } }
    if (extras && l == 0) {
        float* rowss = (float*)(p.ws + OFF_ROWSS);
        bf16_t* xb = (bf16_t*)(p.ws + OFF_XB);
        for (int row = blockIdx.x * 8 + (tid >> 6); row < T; row += gridDim.x * 8) { float ss = 0.f;
#pragma unroll
            for (int i = 0; i < 4; ++i) { const size_t o = (size_t)row * DM + 4 * lane + 256 * i; const f32x4 v = *(const f32x4*)(p.x + o);
                ss += v[0] * v[0] + v[1] * v[1] + v[2] * v[2] + v[3] * v[3]; *(u32x2*)(xb + o) = (u32x2){pk_bf16(v[0], v[1]), pk_bf16(v[2], v[3])}; }
#pragma unroll
            for (int d = 32; d >= 1; d >>= 1) ss += xshfl_f(ss, lane ^ d);
            if (lane < 16) rowss[(((size_t)(row >> 8) * 4 + (lane >> 2)) * 256 + (row & 255)) * 4 + (lane & 3)] = (lane == 0) ? ss : 0.f; }
        float* cs128 = (float*)(p.ws + OFF_CS128); float* cs64 = (float*)(p.ws + OFF_CS64);
        for (int t = blockIdx.x * 512 + tid; t < T; t += gridDim.x * 512) { const double posd = (double)p.pos[t];
#pragma unroll 1
            for (int i = 0; i < 24; ++i) {
                const float ex = (i < 16) ? (float)i * (1.0f / 16.0f) : (float)(i - 16) * (1.0f / 8.0f);
                const float inv_freq = exp2f(-ex * 18.931568569324174f);
                const double ang = posd * (double)inv_freq; const double rev = ang * 0.15915494309189535; const float fr = (float)(rev - floor(rev));
                const float sn = __builtin_amdgcn_sinf(fr), cs = __builtin_amdgcn_cosf(fr);
                float* d = (i < 16) ? cs128 + (size_t)t * 32 + 2 * i : cs64 + (size_t)t * 16 + 2 * (i - 16); d[0] = cs; d[1] = sn; } }
    }
}

__device__ __forceinline__ void rnn_phase(const int wv, const P& p, int l, unsigned char* sm, const bool final) {
    const int tid = GET_TID(wv); const int lane = tid & 63, wid = tid >> 6, fq = lane >> 4, fr = lane & 15;
    bf16_t* WGs = (bf16_t*)sm;
    bf16_t* XAb = (bf16_t*)(sm + 18432);
    float* XAf = (float*)(sm + 27648);
    float* GT = (float*)(sm + 44032);
    float* SEGP = (float*)(sm + 77824);
    float* SEGH = (float*)(sm + 79872);
    float* CAR = (float*)(sm + 81920);
    const bf16_t* RNNX = (const bf16_t*)(p.ws + OFF_RNNX); bf16_t* INA = (bf16_t*)(p.ws + OFF_INB);
    const bf16_t* WRG = (const bf16_t*)(p.ws + OFF_WRG);
    float* RSP = (float*)(p.ws + OFF_RS); float* RSH = RSP + (size_t)NB * NCH * 1024;
    const float* convw = p.rnn_conv_w + (size_t)l * 4 * 1024; const float* convb = p.rnn_conv_b + l * 1024;
    const float* gab = p.ga_b + l * 1024; const float* gxb = p.gx_b + l * 1024; const float* lam = p.lam + l * 1024;
    for (int tix = blockIdx.x; tix < NB * 16 * NCH; tix += gridDim.x) {
        const int n = tix & 15, b = (tix >> 4) & 3, ch = tix >> 6;
#pragma unroll
        for (int q = 0; q < 2; ++q) { const int ck = tid + 512 * q, jp = ck >> 3, i8 = (ck & 7) * 8;
            *(u32x4*)(WGs + jp * 72 + i8) = *(const u32x4*)(WRG + (size_t)n * 8192 + jp * 64 + i8); }
        const int c = tid & 63, seg = tid >> 6;
        const float sp = log1pf(__expf(-lam[64 * n + c]));
        if (tid < 64) { float hc = 0.f;
            if (final) { for (int cc = 0; cc < ch; ++cc) { const size_t o = ((size_t)(b * NCH + cc)) * 1024 + 64 * n + c; hc = RSP[o] * hc + RSH[o]; } }
            CAR[c] = hc; }
        float PC = 1.0f, hlast = 0.f;
        const int ctok = tid >> 3, cc8 = (tid & 7) * 8, ccb = 64 * n + cc8;
        f32x4 cw[4][2], cbv[2]; float gbias[4];
        cbv[0] = *(const f32x4*)(convb + ccb); cbv[1] = *(const f32x4*)(convb + ccb + 4);
#pragma unroll
        for (int k = 0; k < 4; ++k) { cw[k][0] = *(const f32x4*)(convw + k * 1024 + ccb); cw[k][1] = *(const f32x4*)(convw + k * 1024 + ccb + 4); }
#pragma unroll
        for (int q = 0; q < 4; ++q) { const int jp = 16 * (4 * (wid >> 2) + q) + fr; gbias[q] = (jp < 64) ? gab[64 * n + jp] : gxb[64 * n + jp - 64]; }
        u32x4 raw[4];
#define RNN_LOADX(sub_) do { _Pragma("unroll") for (int k = 0; k < 4; ++k) { const int tt = ch * LC + (sub_) * 64 + ctok - 3 + k; \
            raw[k] = (tt >= 0) ? *(const u32x4*)(RNNX + ((size_t)b * S + tt) * 1024 + ccb) : (u32x4){0u, 0u, 0u, 0u}; } } while (0)
        RNN_LOADX(0);
        for (int sub = 0; sub < LC / 64; ++sub) {
            const int t0 = ch * LC + sub * 64; const size_t g0 = (size_t)b * S + t0;
            {
                const int tok = ctok, c8 = cc8; const int cb = ccb;
                float xa[8];
                { const f32x4 b0 = cbv[0], b1 = cbv[1];
                  xa[0] = b0[0]; xa[1] = b0[1]; xa[2] = b0[2]; xa[3] = b0[3]; xa[4] = b1[0]; xa[5] = b1[1]; xa[6] = b1[2]; xa[7] = b1[3]; }
#pragma unroll
                for (int k = 0; k < 4; ++k) {
                        const f32x4 w0 = cw[k][0], w1 = cw[k][1];
                        xa[0] += w0[0] * bf_lo(raw[k][0]); xa[1] += w0[1] * bf_hi(raw[k][0]); xa[2] += w0[2] * bf_lo(raw[k][1]); xa[3] += w0[3] * bf_hi(raw[k][1]);
                        xa[4] += w1[0] * bf_lo(raw[k][2]); xa[5] += w1[1] * bf_hi(raw[k][2]); xa[6] += w1[2] * bf_lo(raw[k][3]); xa[7] += w1[3] * bf_hi(raw[k][3]); }
                *(f32x4*)(XAf + tok * 64 + c8) = (f32x4){xa[0], xa[1], xa[2], xa[3]}; *(f32x4*)(XAf + tok * 64 + c8 + 4) = (f32x4){xa[4], xa[5], xa[6], xa[7]};
                *(u32x4*)(XAb + tok * 72 + c8) = (u32x4){pk_bf16(xa[0], xa[1]), pk_bf16(xa[2], xa[3]), pk_bf16(xa[4], xa[5]), pk_bf16(xa[6], xa[7])};
                if (sub + 1 < LC / 64) RNN_LOADX(sub + 1);
            }
            __syncthreads();
            {
                const int mt = wid & 3;
                const bf16x8 a0 = *(const bf16x8*)(XAb + (16 * mt + fr) * 72 + 8 * fq), a1 = *(const bf16x8*)(XAb + (16 * mt + fr) * 72 + 32 + 8 * fq);
#pragma unroll
                for (int q = 0; q < 4; ++q) { const int ct = 4 * (wid >> 2) + q;
                    const bf16x8 b0 = *(const bf16x8*)(WGs + (16 * ct + fr) * 72 + 8 * fq), b1 = *(const bf16x8*)(WGs + (16 * ct + fr) * 72 + 32 + 8 * fq);
                    f32x4 cacc = {0.f, 0.f, 0.f, 0.f};
                    cacc = __builtin_amdgcn_mfma_f32_16x16x32_bf16(a0, b0, cacc, 0, 0, 0); cacc = __builtin_amdgcn_mfma_f32_16x16x32_bf16(a1, b1, cacc, 0, 0, 0);
                    const int jp = 16 * ct + fr; const float bias = gbias[q];
#pragma unroll
                    for (int r = 0; r < 4; ++r) GT[(16 * mt + 4 * fq + r) * 132 + jp] = sigmoid_f(cacc[r] + bias); }
            }
            __syncthreads();
            unsigned short gv[8];
            if (final) {
#pragma unroll
                for (int k = 0; k < 8; ++k) gv[k] = INA[(g0 + 8 * seg + k) * 1024 + 64 * n + c]; }
            else {
#pragma unroll
                for (int k = 0; k < 8; ++k) gv[k] = 0; }
            float hl[8], pc[8]; float hh = 0.f, pp = 1.0f;
#pragma unroll
            for (int k = 0; k < 8; ++k) { const int tok = 8 * seg + k; const float rg = GT[tok * 132 + c], ig = GT[tok * 132 + 64 + c], xv = XAf[tok * 64 + c];
                const float loga = -8.0f * rg * sp; const float a = __expf(loga); const float x2 = 2.0f * loga;
                const float om = (x2 > -0.25f) ? -x2 * (1.0f + 0.5f * x2 * (1.0f + (1.0f / 3.0f) * x2 * (1.0f + 0.25f * x2 * (1.0f + 0.2f * x2 * (1.0f + (1.0f / 6.0f) * x2))))) : 1.0f - __expf(x2);
                const float sc = __builtin_amdgcn_sqrtf(fmaxf(om, 0.f));
                const float uu = sc * (ig * xv); hh = a * hh + uu; pp *= a; hl[k] = hh; pc[k] = pp; }
            SEGP[seg * 64 + c] = pp; SEGH[seg * 64 + c] = hh;
            __syncthreads();
            float hc = CAR[(sub & 1) * 64 + c];
            for (int s2 = 0; s2 < seg; ++s2) hc = SEGP[s2 * 64 + c] * hc + SEGH[s2 * 64 + c];
            if (final) {
#pragma unroll
                for (int k = 0; k < 8; ++k) { const size_t o = (g0 + 8 * seg + k) * 1024 + 64 * n + c; const float hv = hl[k] + pc[k] * hc;
                    INA[o] = f2bf(hv * bf_lo((unsigned)gv[k])); }
            }
            if (seg == 7) { hlast = hl[7] + pc[7] * hc; CAR[((sub + 1) & 1) * 64 + c] = hlast;
                float pt = 1.0f;
#pragma unroll
                for (int s2 = 0; s2 < 8; ++s2) pt *= SEGP[s2 * 64 + c];
                PC *= pt; }
        }
        __syncthreads();
        if (!final && seg == 7) { const size_t o = ((size_t)(b * NCH + ch)) * 1024 + 64 * n + c; RSP[o] = PC; RSH[o] = hlast; }
    }
}

__device__ __forceinline__ void sconv_phase(const int wv, const P& p, int l) {
    const bf16_t* CCH = (const bf16_t*)(p.ws + OFF_CCH); bf16_t* INBB = (bf16_t*)(p.ws + OFF_INB + (size_t)T * 1024 * 2);
    const float* w = p.sconv_w + (size_t)l * 3 * 1024;
    const int tid = GET_TID(wv);
    for (int e = blockIdx.x * 512 + tid; e < T * 128; e += gridDim.x * 512) {
        const int t = e >> 7, c8 = (e & 127) * 8; const int tt = t & (S - 1);
        float a[8] = {0.f, 0.f, 0.f, 0.f, 0.f, 0.f, 0.f, 0.f};
#pragma unroll
        for (int k = 0; k < 3; ++k) { if (tt - 2 + k >= 0) { const u32x4 raw = *(const u32x4*)(CCH + (size_t)(t - 2 + k) * 1024 + c8);
                const f32x4 w0 = *(const f32x4*)(w + k * 1024 + c8), w1 = *(const f32x4*)(w + k * 1024 + c8 + 4);
                a[0] += w0[0] * bf_lo(raw[0]); a[1] += w0[1] * bf_hi(raw[0]); a[2] += w0[2] * bf_lo(raw[1]); a[3] += w0[3] * bf_hi(raw[1]);
                a[4] += w1[0] * bf_lo(raw[2]); a[5] += w1[1] * bf_hi(raw[2]); a[6] += w1[2] * bf_lo(raw[3]); a[7] += w1[3] * bf_hi(raw[3]); } }
        const u32x4 cb = *(const u32x4*)(INBB + (size_t)t * 1024 + c8);
        const u32x4 o = {pk_bf16(a[0] * bf_lo(cb[0]), a[1] * bf_hi(cb[0])), pk_bf16(a[2] * bf_lo(cb[1]), a[3] * bf_hi(cb[1])),
                         pk_bf16(a[4] * bf_lo(cb[2]), a[5] * bf_hi(cb[2])), pk_bf16(a[6] * bf_lo(cb[3]), a[7] * bf_hi(cb[3]))};
        *(u32x4*)(INBB + (size_t)t * 1024 + c8) = o;
    }
}

__device__ __forceinline__ unsigned mono_key(float f) { unsigned u = __float_as_uint(f); if (u == 0x80000000u) u = 0u; return (u & 0x80000000u) ? ~u : (u | 0x80000000u); }

__device__ __forceinline__ void att_phase(const int wv, const P& p, unsigned char* sm) {
    const int tid = GET_TID(wv); const int lane = tid & 63, wid = tid >> 6, fq = lane >> 4, fr = lane & 15;
    float* SC = (float*)sm;
    LAS unsigned* HIST = (LAS unsigned*)(LAS unsigned char*)(sm + 131072);
    unsigned* IDX = (unsigned*)(sm + 131072 + 8192);
    const bf16_t* QI = (const bf16_t*)(p.ws + OFF_QI); const bf16_t* KI = (const bf16_t*)(p.ws + OFF_KI); const float* WI = (const float*)(p.ws + OFF_WI);
    const bf16_t* Q = (const bf16_t*)(p.ws + OFF_Q); bf16_t* AO = (bf16_t*)(p.ws + OFF_CCH); const bf16_t* KB = (const bf16_t*)(p.ws + OFF_KB); const bf16_t* VB = (const bf16_t*)(p.ws + OFF_VB);
    const unsigned long long ltmask = (1ull << lane) - 1ull;
    *(LAS u32x4*)(HIST + 4 * tid) = (u32x4){0u, 0u, 0u, 0u};
    __syncthreads();
    for (int tix = blockIdx.x; tix < NB * (S / 8); tix += gridDim.x) {
        const int id = NB * (S / 8) - 1 - tix; const int b = id & 3, qg = id >> 2, t0 = qg * 8; const size_t gt0 = (size_t)b * S + t0;
        {
            bf16x8 qa[4][2]; f32x4 wv[4];
#pragma unroll
            for (int mt = 0; mt < 4; ++mt) { const int ql = 2 * mt + (fr >> 3), hd = fr & 7;
#pragma unroll
                for (int ks = 0; ks < 2; ++ks) qa[mt][ks] = *(const bf16x8*)(QI + (gt0 + ql) * 512 + hd * 64 + 32 * ks + 8 * fq);
                wv[mt] = *(const f32x4*)(WI + (gt0 + 2 * mt + (fq >> 1)) * 8 + 4 * (fq & 1)); }
            const int nkt = (t0 + 8 + 15) >> 4;
            const bf16_t* kibase = KI + (size_t)b * S * 64 + (fq * 16 + fr) * 8;
            bf16x8 nb0, nb1; { const int kb = min(wid, S / 16 - 1); nb0 = *(const bf16x8*)(kibase + (size_t)kb * 1024); nb1 = *(const bf16x8*)(kibase + (size_t)kb * 1024 + 512); }
            for (int kt = wid; kt < nkt; kt += 8) { const int key = 16 * kt + fr;
                const bf16x8 kb0 = nb0, kb1 = nb1;
                { const int kb = min(kt + 8, S / 16 - 1); nb0 = *(const bf16x8*)(kibase + (size_t)kb * 1024); nb1 = *(const bf16x8*)(kibase + (size_t)kb * 1024 + 512); }
#pragma unroll
                for (int mp = 0; mp < 2; ++mp) {
                    float part[2];
#pragma unroll
                    for (int hh = 0; hh < 2; ++hh) { const int mt = 2 * mp + hh; f32x4 cacc = {0.f, 0.f, 0.f, 0.f};
                        cacc = __builtin_amdgcn_mfma_f32_16x16x32_bf16(qa[mt][0], kb0, cacc, 0, 0, 0); cacc = __builtin_amdgcn_mfma_f32_16x16x32_bf16(qa[mt][1], kb1, cacc, 0, 0, 0);
                        part[hh] = wv[mt][0] * fmaxf(cacc[0], 0.f) + wv[mt][1] * fmaxf(cacc[1], 0.f) + wv[mt][2] * fmaxf(cacc[2], 0.f) + wv[mt][3] * fmaxf(cacc[3], 0.f); }
                    const bool odd = (fq & 1) != 0;
                    const float recv = xshfl_f(odd ? part[0] : part[1], lane ^ 16);
                    const float tot = odd ? (recv + part[1]) : (part[0] + recv);
                    const int ql = 2 * (2 * mp + (odd ? 1 : 0)) + (fq >> 1); const unsigned kbits = mono_key(tot);
                    SC[ql * 4096 + key] = __uint_as_float(kbits);
                    if (key <= t0 + ql) __hip_atomic_fetch_add(HIST + ql * 256 + (kbits >> 24), 1u, __ATOMIC_RELAXED, __HIP_MEMORY_SCOPE_WORKGROUP); } }
        }
        __syncthreads();
        {
            const int t = t0 + wid, n = t + 1; const size_t gt = gt0 + wid;
            float* sc = SC + wid * 4096; LAS unsigned* hist = HIST + wid * 256; unsigned* idx = IDX + wid * 256;
            int nsel;
            if (n <= 256) { for (int i = lane; i < 256; i += 64) idx[i] = (i < n) ? (unsigned)i : 0u; nsel = n; }
            else {
                unsigned prefix = 0u, remaining = 256u;
#define SEL_FIND_BIN() do { LDS_FENCE(); const u32x4 h4 = *(const LAS u32x4*)(hist + 4 * lane); \
        const unsigned s_ = h4[0] + h4[1] + h4[2] + h4[3]; unsigned suf = s_; \
        _Pragma("unroll") for (int d = 1; d < 64; d <<= 1) { const unsigned v = xshfl_u(suf, (lane + d) & 63); if (lane + d < 64) suf += v; } \
        const unsigned long long mask = __ballot(suf >= remaining); const int L = 63 - __clzll(mask); \
        unsigned cum = suf - s_; int bsel; \
        if (cum + h4[3] >= remaining) bsel = 3; else { cum += h4[3]; if (cum + h4[2] >= remaining) bsel = 2; else { cum += h4[2]; if (cum + h4[1] >= remaining) bsel = 1; else { cum += h4[1]; bsel = 0; } } } \
        bsel = (int)xshfl_u((unsigned)bsel, L); cum = xshfl_u(cum, L); \
        remaining -= cum; binsel = (unsigned)(4 * L + bsel); } while (0)
                unsigned binsel;
                SEL_FIND_BIN(); prefix = binsel;
                {   const int shift = 16;
                    *(LAS u32x4*)(hist + 4 * lane) = (u32x4){0u, 0u, 0u, 0u};
                    LDS_FENCE();
                    for (int i0 = lane; i0 < n; i0 += 512) { float sv[8];
#pragma unroll
                        for (int q = 0; q < 8; ++q) sv[q] = sc[min(i0 + 64 * q, 4095)];
#pragma unroll
                        for (int q = 0; q < 8; ++q) { const unsigned k = __float_as_uint(sv[q]);
                            if (i0 + 64 * q < n && (k >> 24) == prefix) __hip_atomic_fetch_add(hist + ((k >> shift) & 255u), 1u, __ATOMIC_RELAXED, __HIP_MEMORY_SCOPE_WORKGROUP); } }
                    SEL_FIND_BIN(); prefix = (prefix << 8) | binsel; }
                unsigned base = 0u, C = 0u;
                for (int i0 = 0; i0 < n; i0 += 512) { float sv[8];
#pragma unroll
                    for (int q = 0; q < 8; ++q) sv[q] = sc[min(i0 + 64 * q + lane, 4095)];
                    LDS_FENCE();
#pragma unroll
                    for (int q = 0; q < 8; ++q) { const int i = i0 + 64 * q + lane; const bool valid = i < n; const unsigned k = valid ? __float_as_uint(sv[q]) : 0u;
                        const bool gtr = valid && (k >> 16) > prefix, eq = valid && (k >> 16) == prefix;
                        const unsigned long long smk = __ballot(gtr); const unsigned pos = base + (unsigned)__popcll(smk & ltmask);
                        if (gtr && pos < 256u) idx[pos] = (unsigned)i; base += (unsigned)__popcll(smk);
                        const unsigned long long em = __ballot(eq); const unsigned cpos = C + (unsigned)__popcll(em & ltmask);
                        if (eq) sc[cpos] = __uint_as_float(((k & 0xffffu) << 12) | (unsigned)i); C += (unsigned)__popcll(em); } }
                unsigned lp = 0u;
                for (int pass = 0; pass < 2; ++pass) { const int shift = 8 - 8 * pass;
                    *(LAS u32x4*)(hist + 4 * lane) = (u32x4){0u, 0u, 0u, 0u};
                    LDS_FENCE();
                    for (unsigned j = lane; j < C; j += 64) { const unsigned low = __float_as_uint(sc[j]) >> 12;
                        if (pass == 0 || (low >> 8) == lp) __hip_atomic_fetch_add(hist + ((low >> shift) & 255u), 1u, __ATOMIC_RELAXED, __HIP_MEMORY_SCOPE_WORKGROUP); }
                    SEL_FIND_BIN(); lp = (lp << 8) | binsel; }
                unsigned eqbase = 0u;
                for (unsigned j0 = 0; j0 < C; j0 += 64) { const unsigned j = j0 + lane; const bool valid = j < C; const unsigned w = valid ? __float_as_uint(sc[j]) : 0u;
                    const unsigned low = w >> 12; const bool gtr = valid && low > lp, eq = valid && low == lp;
                    const unsigned long long em = __ballot(eq); const unsigned er = eqbase + (unsigned)__popcll(em & ltmask);
                    const bool sel = gtr || (eq && er < remaining);
                    const unsigned long long smk = __ballot(sel); const unsigned pos = base + (unsigned)__popcll(smk & ltmask);
                    if (sel && pos < 256u) idx[pos] = w & 4095u; base += (unsigned)__popcll(smk); eqbase += (unsigned)__popcll(em); }
#undef SEL_FIND_BIN
                nsel = 256;
            }
            LDS_FENCE();
            bf16x8 qf[2][4];
#pragma unroll
            for (int g = 0; g < 2; ++g)
#pragma unroll
                for (int ks = 0; ks < 4; ++ks) qf[g][ks] = *(const bf16x8*)(Q + gt * 1024 + (4 * g + (fr & 3)) * 128 + 32 * ks + 8 * fq);
            float* P1 = sc; float* P2 = sc + 2048; bf16_t* Pb = (bf16_t*)(sc + 2048);
            const int nkt2 = (nsel + 15) >> 4;
            {
                const bf16_t* kbase = KB + (size_t)b * S * 256 + 8 * (lane & 31);
                unsigned char* stage = (unsigned char*)(sc + 2048);
                const int hrow = lane >> 5, chunk = lane & 31;
                bf16x8 kc[8], kn[8];
#define QK_LOAD(dst, kt_) do { _Pragma("unroll") for (int q_ = 0; q_ < 8; ++q_) { const unsigned kx_ = idx[16 * (kt_) + 2 * q_ + hrow]; \
        dst[q_] = *(const bf16x8*)(kbase + (size_t)kx_ * 256); } } while (0)
#define QK_MMA(srcv, kt_) do { LDS_FENCE(); \
        _Pragma("unroll") for (int q_ = 0; q_ < 8; ++q_) { const int r_ = 2 * q_ + hrow; *(bf16x8*)(stage + r_ * 512 + ((chunk & 16) | ((chunk ^ r_) & 15)) * 16) = srcv[q_]; } \
        LDS_FENCE(); \
        __builtin_amdgcn_s_setprio(1); \
        _Pragma("unroll") for (int g = 0; g < 2; ++g) { f32x4 cacc = {0.f, 0.f, 0.f, 0.f}; \
        _Pragma("unroll") for (int ks = 0; ks < 4; ++ks) { const int c_ = g * 16 + ks * 4 + fq; \
            const bf16x8 af = *(const bf16x8*)(stage + fr * 512 + ((c_ & 16) | ((c_ ^ fr) & 15)) * 16); \
            cacc = __builtin_amdgcn_mfma_f32_16x16x32_bf16(af, qf[g][ks], cacc, 0, 0, 0); } \
        if (fr < 4) { _Pragma("unroll") for (int r = 0; r < 4; ++r) P1[(4 * g + fr) * 256 + 16 * (kt_) + 4 * fq + r] = cacc[r]; } } __builtin_amdgcn_s_setprio(0); } while (0)
                QK_LOAD(kc, 0);
                for (int kt = 0; kt < nkt2; kt += 2) {
                    QK_LOAD(kn, min(kt + 1, 15));
                    QK_MMA(kc, kt);
                    QK_LOAD(kc, min(kt + 2, 15));
                    if (kt + 1 < nkt2) QK_MMA(kn, kt + 1);
                }
#undef QK_LOAD
#undef QK_MMA
            }
            LDS_FENCE();
#pragma unroll
            for (int h = 0; h < 8; ++h) { float v[4]; float mx = -3.0e38f;
#pragma unroll
                for (int jj = 0; jj < 4; ++jj) { const int sl = lane + 64 * jj; v[jj] = (sl < nsel) ? P1[h * 256 + sl] : -3.0e38f; mx = fmaxf(mx, v[jj]); }
#pragma unroll
                for (int d = 32; d >= 1; d >>= 1) mx = fmaxf(mx, xshfl_f(mx, lane ^ d));
                float e[4], sum = 0.f;
#pragma unroll
                for (int jj = 0; jj < 4; ++jj) { const int sl = lane + 64 * jj; e[jj] = (sl < nsel) ? __expf(v[jj] - mx) : 0.f; sum += e[jj]; }
#pragma unroll
                for (int d = 32; d >= 1; d >>= 1) sum += xshfl_f(sum, lane ^ d);
                const float inv = 1.0f / sum;
#pragma unroll
                for (int jj = 0; jj < 4; ++jj) Pb[h * 264 + lane + 64 * jj] = f2bf(e[jj] * inv); }
            LDS_FENCE();
            {
                unsigned char* vst = (unsigned char*)sc;
                const bf16_t* vbase = VB + (size_t)b * S * 256 + 8 * (lane & 15);
                const int srow = lane >> 4;
                f32x4 oacc[2][8];
#pragma unroll
                for (int g = 0; g < 2; ++g)
#pragma unroll
                    for (int dt = 0; dt < 8; ++dt) oacc[g][dt] = (f32x4){0.f, 0.f, 0.f, 0.f};
                const int nstep = (nsel + 31) >> 5;
                bf16x8 vc[8], vn[8];
#define PV_LOAD(dst, st_, g_) do { _Pragma("unroll") for (int i_ = 0; i_ < 8; ++i_) { const unsigned kx_ = idx[32 * (st_) + 4 * i_ + srow]; \
        dst[i_] = *(const bf16x8*)(vbase + (size_t)kx_ * 256 + (g_) * 128); } } while (0)
#define PV_MMA(srcv, st_, g_) do { LDS_FENCE(); \
        _Pragma("unroll") for (int i_ = 0; i_ < 8; ++i_) { const int rw_ = 4 * i_ + srow; *(bf16x8*)(vst + rw_ * 256 + (((lane & 15) ^ (((rw_ & 3) << 2) | ((rw_ >> 2) & 3))) * 16)) = srcv[i_]; } \
        LDS_FENCE(); \
        const bf16x8 af = *(const bf16x8*)(Pb + ((g_) * 4 + (fr & 3)) * 264 + 32 * (st_) + 8 * fq); __builtin_amdgcn_s_setprio(1); \
        _Pragma("unroll") for (int dt = 0; dt < 8; ++dt) { \
            const int r0_ = 8 * fq + (fr >> 2), r1_ = r0_ + 4, ch_ = 2 * dt + ((fr & 3) >> 1); \
            const LAS s16x4* ta_ = (const LAS s16x4*)(LAS unsigned char*)(vst + r0_ * 256 + ((ch_ ^ (((r0_ & 3) << 2) | ((r0_ >> 2) & 3))) * 16) + (fr & 1) * 8); \
            const LAS s16x4* tb_ = (const LAS s16x4*)(LAS unsigned char*)(vst + r1_ * 256 + ((ch_ ^ (((r1_ & 3) << 2) | ((r1_ >> 2) & 3))) * 16) + (fr & 1) * 8); \
            const s16x4 t0_ = __builtin_amdgcn_ds_read_tr16_b64_v4i16((LAS s16x4*)ta_), t1_ = __builtin_amdgcn_ds_read_tr16_b64_v4i16((LAS s16x4*)tb_); \
            const bf16x8 bfv = __builtin_shufflevector(t0_, t1_, 0, 1, 2, 3, 4, 5, 6, 7); \
            oacc[g_][dt] = __builtin_amdgcn_mfma_f32_16x16x32_bf16(af, bfv, oacc[g_][dt], 0, 0, 0); } __builtin_amdgcn_s_setprio(0); } while (0)
                PV_LOAD(vc, 0, 0);
                for (int st = 0; st < nstep; ++st) {
                    PV_LOAD(vn, st, 1);
                    PV_MMA(vc, st, 0);
                    PV_LOAD(vc, min(st + 1, 7), 0);
                    PV_MMA(vn, st, 1);
                }
#undef PV_LOAD
#undef PV_MMA
                if (fq == 0) {
#pragma unroll
                    for (int g = 0; g < 2; ++g)
#pragma unroll
                        for (int dt = 0; dt < 8; ++dt)
#pragma unroll
                            for (int r = 0; r < 4; ++r) AO[gt * 1024 + (4 * g + r) * 128 + 16 * dt + fr] = f2bf(oacc[g][dt][r]);
                }
            }
            LDS_FENCE(); *(LAS u32x4*)(hist + 4 * lane) = (u32x4){0u, 0u, 0u, 0u};
        }
        __syncthreads();
    }
}

__device__ __forceinline__ void gsync(cg::grid_group& grid) {
    asm volatile("s_waitcnt vmcnt(0) lgkmcnt(0)" ::: "memory");
    grid.sync();
    if (__builtin_amdgcn_readfirstlane(threadIdx.x >> 6) == 0) { __builtin_amdgcn_fence(__ATOMIC_ACQUIRE, "agent"); asm volatile("s_waitcnt vmcnt(0) lgkmcnt(0)" ::: "memory"); }
    __syncthreads();
}

#define XB_TMO      128
#define XB_XCNT(j)  (256  + 64 * (j))
#define XB_XSUB(j)  (1280 + 64 * (j))
#define XB_XGEN(j)  (2304 + 64 * (j))
#define XB_TOP      3328
#define XB_TOPGEN   3392
#define XCD_BAR_WORDS 3456
#define XB_SPIN_CAP (1u << 18)
__device__ __forceinline__ unsigned xb_ld(unsigned* p)              { return __hip_atomic_load(p, __ATOMIC_RELAXED, __HIP_MEMORY_SCOPE_AGENT); }
__device__ __forceinline__ unsigned xb_add(unsigned* p, unsigned v) { return __hip_atomic_fetch_add(p, v, __ATOMIC_RELAXED, __HIP_MEMORY_SCOPE_AGENT); }
__device__ __forceinline__ unsigned xb_xcc_id() { return (unsigned)__builtin_amdgcn_s_getreg((3 << 11) | 20) & 0xFu; }
#define XB_SPIN(cond, bar) do { unsigned _sp = 0; while (cond) { __builtin_amdgcn_s_sleep(1); \
    if ((++_sp & 255u) == 0u) { if (xb_ld(&(bar)[XB_TMO])) break; if (_sp > XB_SPIN_CAP) { atomicAdd(&(bar)[XB_TMO], 1u); break; } } } } while (0)
__device__ __forceinline__ void xcd_barrier_complete(unsigned* bar, unsigned x, unsigned& nloc, unsigned& nx) {
    const unsigned G = gridDim.x * gridDim.y * gridDim.z;
    unsigned sum, cnt, mine, sp = 0u;
    for (;;) {
        sum = 0u; cnt = 0u; mine = 0u;
#pragma unroll
        for (unsigned j = 0; j < 16; ++j) { const unsigned c = xb_ld(&bar[XB_XCNT(j)]); sum += c; cnt += (c > 0u) ? 1u : 0u; mine = (j == x) ? c : mine; }
        if (sum == G) break;
        __builtin_amdgcn_s_sleep(1);
        if ((++sp & 255u) == 0u) { if (xb_ld(&bar[XB_TMO])) break; if (sp > XB_SPIN_CAP) { atomicAdd(&bar[XB_TMO], 1u); break; } }
    }
    nloc = mine > 0u ? mine : 1u; nx = cnt > 0u ? cnt : 1u;
}
__device__ __forceinline__ void xsync(unsigned* bar, volatile LAS unsigned* st) {
    asm volatile("s_waitcnt vmcnt(0) lgkmcnt(0)" ::: "memory");
    __syncthreads();
    if (threadIdx.x == 0) {
        const unsigned x = xb_xcc_id();
        __builtin_amdgcn_s_waitcnt(0);
        unsigned nloc = st[0], nx = st[1];
        if (nloc == 0u) { xcd_barrier_complete(bar, x, nloc, nx); st[0] = nloc; st[1] = nx; }
        const unsigned old = xb_add(&bar[XB_XSUB(x)], 1u);
        const unsigned gen = old / nloc;
        if (old + 1u == (gen + 1u) * nloc) {
            __builtin_amdgcn_fence(__ATOMIC_RELEASE, "agent");
            asm volatile("s_waitcnt vmcnt(0)" ::: "memory");
            const unsigned og = xb_add(&bar[XB_TOP], 1u);
            const unsigned tg = og / nx;
            if (og + 1u == (tg + 1u) * nx) xb_add(&bar[XB_TOPGEN], 1u);
            else XB_SPIN(xb_ld(&bar[XB_TOPGEN]) == tg, bar);
            __builtin_amdgcn_fence(__ATOMIC_ACQUIRE, "agent");
            xb_add(&bar[XB_XGEN(x)], 1u);
            asm volatile("s_waitcnt vmcnt(0)" ::: "memory");
        } else {
            XB_SPIN(xb_ld(&bar[XB_XGEN(x)]) == gen, bar);
            __builtin_amdgcn_fence(__ATOMIC_ACQUIRE, "agent");
            asm volatile("s_waitcnt vmcnt(0)" ::: "memory");
        }
    }
    __syncthreads();
}

#define CAS __attribute__((address_space(4)))
#if defined(__HIP_DEVICE_COMPILE__)
#define LOADP_COPY(dst, srcp) __builtin_memcpy(&(dst), (srcp), sizeof(P))
#else
#define LOADP_COPY(dst, srcp) ((void)(srcp))
#endif
#define LOADP() P pl; { const CAS P* q_ = (const CAS P*)__builtin_amdgcn_kernarg_segment_ptr(); asm volatile("" : "+s"(q_)); LOADP_COPY(pl, q_); } \
    unsigned char* const ws = pl.ws; float* const rowss = (float*)(ws + OFF_ROWSS); const int G = gridDim.x, c = blockIdx.x; (void)rowss; (void)G; (void)c;
__global__ void __launch_bounds__(512, 2) mk_forward(P p_unused) {
    cg::grid_group grid = cg::this_grid();
    extern __shared__ __attribute__((aligned(16))) unsigned char shm[];
    LAS unsigned char* lds = (LAS unsigned char*)shm;
    const int wv = __builtin_amdgcn_readfirstlane(threadIdx.x >> 6);
    volatile LAS unsigned* xst = (volatile LAS unsigned*)(lds + 147456);
    if (threadIdx.x == 0) { xst[0] = 0u; xst[1] = 0u; xst[2] = 0u; xst[3] = 0u; }
    __syncthreads();
    { LOADP(); if (threadIdx.x == 0) (void)xb_add(&((unsigned*)(ws + OFF_BAR))[XB_XCNT(xb_xcc_id())], 1u); }
    { LOADP(); if (pl.out == nullptr) gsync(grid); }
#define XSYNC() do { LOADP(); xsync((unsigned*)(ws + OFF_BAR), xst); } while (0)
    for (int l = 0; l < 2; ++l) {
        { LOADP(); prep_phase(wv, pl, l, shm, (l == 1 && G == 256) ? 0x183u : 0x1FFu, c, G, true); }
        XSYNC();
        for (int f = 0; f < 2; ++f) {
            if (f == 1) {
                { LOADP(); PlainOrder so; so.to.init(T, 7424, G, c); so.A = (const char*)(ws + OFF_XB); so.B = (const char*)(ws + OFF_WIN); so.tstep = (size_t)256 * 1024 * 2;
                  EpiWin e; e.rowss = rowss + (size_t)(3 * l + 1) * T * 16; e.ws = ws; gemm_phase(wv, lds, 1024, so, e); }
                XSYNC();
                { LOADP(); rnn_phase(wv, pl, l, shm, false); }
                { LOADP(); sconv_phase(wv, pl, l); }
                XSYNC();
                { LOADP(); rnn_phase(wv, pl, l, shm, true); }
                { LOADP(); att_phase(wv, pl, shm); }
                XSYNC();
                { LOADP(); Out3Order so; so.to.init(T, 1024, G, c); so.xb = (const char*)(ws + OFF_XB); so.wing = (const char*)(ws + OFF_WIN + (size_t)7424 * 1024 * 2);
                  so.inb = (const char*)(ws + OFF_INB); so.inc = (const char*)(ws + OFF_CCH); so.wout = (const char*)(ws + OFF_WOUT3);
                  EpiOut3 e; e.rowss = rowss + (size_t)(3 * l + 1) * T * 16; e.G = (bf16_t*)(ws + OFF_RNNX); e.M = (float*)(ws + OFF_Q); gemm_phase(wv, lds, 1024, so, e); }
                XSYNC();
                { LOADP(); PlainOrder so; so.to.init(T, 1024, G, c); so.A = (const char*)(ws + OFF_RNNX); so.B = (const char*)(ws + OFF_WO); so.tstep = (size_t)256 * 1024 * 2;
                  EpiResid e; e.xin = pl.out; e.xout = pl.out; e.xb = (bf16_t*)(ws + OFF_XB); e.rowss_next = rowss + (size_t)(3 * l + 2) * T * 16; e.scale = 1.0f; gemm_phase(wv, lds, 1024, so, e); }
                XSYNC();
            }
            { LOADP(); PlainOrder so; so.to.init(T, 5632, G, c); so.A = (const char*)(ws + OFF_XB); so.B = (const char*)(ws + (f ? OFF_WGU2 : OFF_WGU1)); so.tstep = (size_t)256 * 1024 * 2;
              EpiFfnUp e; e.H = (bf16_t*)(ws + OFF_H); e.rowss = rowss + (size_t)(3 * l + 2 * f) * T * 16; gemm_phase(wv, lds, 1024, so, e); }
            if (l == 0 && f == 1 && gridDim.x == 256 && (int)blockIdx.x >= 128) { LOADP(); prep_phase(wv, pl, 1, shm, 0x07Cu, c - 128, 128, false); }
            XSYNC();
            { LOADP(); PlainOrder so; so.to.init(T, 1024, G, c); so.A = (const char*)(ws + OFF_H); so.B = (const char*)(ws + (f ? OFF_WD2 : OFF_WD1)); so.tstep = (size_t)256 * 2816 * 2;
              EpiResid e; e.xin = (l == 0 && f == 0) ? pl.x : pl.out; e.xout = pl.out; e.xb = (bf16_t*)(ws + OFF_XB); e.rowss_next = rowss + (size_t)(3 * l + 2 * f + 1) * T * 16; e.scale = 0.5f; gemm_phase(wv, lds, 2816, so, e); }
            XSYNC();
        }
    }
    { LOADP(); const float* rs = rowss + (size_t)6 * T * 16;
      const int tid = GET_TID(wv);
      for (int e = blockIdx.x * 512 + tid; e < T * 256; e += gridDim.x * 512) { const int row = e >> 8, c4 = (e & 255) * 4; const float r = rinv_of(rs, row);
          f32x4 v = *(const f32x4*)(pl.out + (size_t)row * DM + c4); const f32x4 g = *(const f32x4*)(pl.final_norm + c4); v = v * r * g; *(f32x4*)(pl.out + (size_t)row * DM + c4) = v; } }
}

extern "C" void kernel_launch(void* const* d_in, const int* in_sizes, int n_in, void* d_out, int out_size, void* d_ws, size_t ws_size, hipStream_t stream) {
    static int grid_blocks = 0;
    if (!grid_blocks) {
        (void)hipFuncSetAttribute((const void*)mk_forward, hipFuncAttributeMaxDynamicSharedMemorySize, (int)DYN_LDS);
        int dev = 0, cus = 0, per_cu = 0; (void)hipGetDevice(&dev);
        (void)hipDeviceGetAttribute(&cus, hipDeviceAttributeMultiprocessorCount, dev);
        (void)hipOccupancyMaxActiveBlocksPerMultiprocessor(&per_cu, mk_forward, 512, DYN_LDS);
        if (per_cu > 1) per_cu = 1;
        grid_blocks = cus * per_cu;
    }
    if (ws_size < WS_NEED || n_in < 23) return;
    P p{};
    p.x = (const float*)d_in[0]; p.pos = (const int*)d_in[1];
    p.ffn1_norm = (const float*)d_in[2]; p.ffn1_gu = (const float*)d_in[3]; p.ffn1_dn = (const float*)d_in[4]; p.mix_norm = (const float*)d_in[5]; p.w_in = (const float*)d_in[6];
    p.rnn_conv_w = (const float*)d_in[7]; p.rnn_conv_b = (const float*)d_in[8]; p.ga_w = (const float*)d_in[9]; p.ga_b = (const float*)d_in[10]; p.gx_w = (const float*)d_in[11]; p.gx_b = (const float*)d_in[12];
    p.lam = (const float*)d_in[13]; p.rnn_w_out = (const float*)d_in[14]; p.sconv_w = (const float*)d_in[15]; p.sconv_w_out = (const float*)d_in[16]; p.attn_w_out = (const float*)d_in[17]; p.w_o = (const float*)d_in[18];
    p.ffn2_norm = (const float*)d_in[19]; p.ffn2_gu = (const float*)d_in[20]; p.ffn2_dn = (const float*)d_in[21]; p.final_norm = (const float*)d_in[22];
    p.out = (float*)d_out; p.ws = (unsigned char*)d_ws;
    (void)hipMemsetAsync((unsigned char*)d_ws + OFF_BAR, 0, 16384, stream);
    void* args[] = {&p};
    (void)hipLaunchCooperativeKernel((void*)mk_forward, dim3(grid_blocks), dim3(512), args, DYN_LDS, stream);
}
```

```cpp
#include <hip/hip_runtime.h>
#include <hip/hip_cooperative_groups.h>
namespace cg = cooperative_groups;

#define LAS __attribute__((address_space(3)))
typedef unsigned short bf16_t;
typedef short bf16x8 __attribute__((ext_vector_type(8)));
typedef short s16x4 __attribute__((ext_vector_type(4)));
typedef float f32x4 __attribute__((ext_vector_type(4)));
typedef unsigned u32x4 __attribute__((ext_vector_type(4)));
typedef unsigned u32x2 __attribute__((ext_vector_type(2)));
typedef float f32x2 __attribute__((ext_vector_type(2)));

constexpr int T = 16384, S = 4096, NB = 4, DM = 1024, DFF = 2816;
constexpr int LC = 512, NCH = S / LC;
constexpr size_t DYN_LDS = 147456 + 256;

constexpr size_t OFF_WGU1 = 0;
constexpr size_t OFF_WD1 = OFF_WGU1 + (size_t)5632 * 1024 * 2;
constexpr size_t OFF_WIN = OFF_WD1 + (size_t)1024 * 2816 * 2;
constexpr size_t OFF_WOUT3 = OFF_WIN + (size_t)10496 * 1024 * 2;
constexpr size_t OFF_WO = OFF_WOUT3 + (size_t)3 * 1024 * 1024 * 2;
constexpr size_t OFF_WGU2 = OFF_WO + (size_t)1024 * 1024 * 2;
constexpr size_t OFF_WD2 = OFF_WGU2 + (size_t)5632 * 1024 * 2;
constexpr size_t OFF_WRG = OFF_WD2 + (size_t)1024 * 2816 * 2;
constexpr size_t OFF_XB = OFF_WRG + (size_t)16 * 128 * 64 * 2;
constexpr size_t OFF_ROWSS = OFF_XB + (size_t)T * 1024 * 2;
constexpr size_t OFF_CS128 = OFF_ROWSS + (size_t)7 * T * 16 * 4;
constexpr size_t OFF_CS64 = OFF_CS128 + (size_t)T * 16 * 8;
constexpr size_t OFF_RS = OFF_CS64 + (size_t)T * 8 * 8;
constexpr size_t OFF_BIG = OFF_RS + (size_t)NB * NCH * 1024 * 2 * 4;
constexpr size_t OFF_H = OFF_BIG;
constexpr size_t OFF_RNNX = OFF_BIG;
constexpr size_t OFF_INB = OFF_RNNX + (size_t)T * 1024 * 2;
constexpr size_t OFF_CCH = OFF_INB + (size_t)2 * T * 1024 * 2;
constexpr size_t OFF_Q = OFF_CCH + (size_t)T * 1024 * 2;
constexpr size_t OFF_KB = OFF_Q + (size_t)T * 1024 * 2;
constexpr size_t OFF_VB = OFF_KB + (size_t)T * 256 * 2;
constexpr size_t OFF_QI = OFF_VB + (size_t)T * 256 * 2;
constexpr size_t OFF_KI = OFF_QI + (size_t)T * 512 * 2;
constexpr size_t OFF_WI = OFF_KI + (size_t)T * 64 * 2;
constexpr size_t OFF_BAR = OFF_WI + (size_t)T * 8 * 4;
constexpr size_t WS_NEED = OFF_BAR + 16384;

struct P {
    const float* x; const int* pos;
    const float* ffn1_norm; const float* ffn1_gu; const float* ffn1_dn; const float* mix_norm; const float* w_in;
    const float* rnn_conv_w; const float* rnn_conv_b; const float* ga_w; const float* ga_b; const float* gx_w; const float* gx_b; const float* lam;
    const float* rnn_w_out; const float* sconv_w; const float* sconv_w_out; const float* attn_w_out; const float* w_o;
    const float* ffn2_norm; const float* ffn2_gu; const float* ffn2_dn; const float* final_norm;
    float* out; unsigned char* ws;
};

__device__ __forceinline__ unsigned pk_bf16(float lo, float hi) { unsigned r; asm("v_cvt_pk_bf16_f32 %0, %1, %2" : "=v"(r) : "v"(lo), "v"(hi)); return r; }
__device__ __forceinline__ bf16_t f2bf(float f) { return (bf16_t)(pk_bf16(f, 0.f) & 0xffffu); }
__device__ __forceinline__ float bf_lo(unsigned u) { return __uint_as_float(u << 16); }
__device__ __forceinline__ float bf_hi(unsigned u) { return __uint_as_float(u & 0xffff0000u); }
__device__ __forceinline__ float fast_rcp(float x) { return __builtin_amdgcn_rcpf(x); }
__device__ __forceinline__ float sigmoid_f(float x) { return fast_rcp(1.0f + __expf(-x)); }
__device__ __forceinline__ float silu_f(float x) { return x * sigmoid_f(x); }
__device__ __forceinline__ float gelu_tanh_f(float x) { return x * sigmoid_f(1.5957691216f * (x + 0.044715f * x * x * x)); }
__device__ __forceinline__ float rinv_of(const float* rowss, int row) {
    const f32x4* q = (const f32x4*)(rowss + ((size_t)(row >> 8) * 4 * 256 + (row & 255)) * 4); const f32x4 a = q[0], b = q[256], c = q[512], d = q[768];
    const float s = ((a[0] + a[1]) + (a[2] + a[3])) + ((b[0] + b[1]) + (b[2] + b[3])) + ((c[0] + c[1]) + (c[2] + c[3])) + ((d[0] + d[1]) + (d[2] + d[3]));
    return rsqrtf(s * (1.0f / 1024.0f) + 1e-6f); }
__device__ __forceinline__ int lane_id() { unsigned m = ~0u; asm volatile("" : "+s"(m)); return (int)__builtin_amdgcn_mbcnt_hi(m, __builtin_amdgcn_mbcnt_lo(m, 0u)); }
__device__ __forceinline__ float xshfl_f(float v, int src) { return __int_as_float(__builtin_amdgcn_ds_bpermute(src << 2, __float_as_int(v))); }
__device__ __forceinline__ unsigned xshfl_u(unsigned v, int src) { return (unsigned)__builtin_amdgcn_ds_bpermute(src << 2, (int)v); }
#define GET_TID(wv) ({ int w_ = (wv); asm volatile("" : "+s"(w_)); int t_ = w_ * 64 + lane_id(); asm volatile("" : "+v"(t_)); t_; })
__device__ __forceinline__ void load_rinv8(const float* rowss, int row0, int fq, int ln, float (&rv)[8]) {
    f32x4 p[8];
#pragma unroll
    for (int i = 0; i < 8; ++i) { const int row = row0 + (i >> 2) * 128 + (i & 3) * 16; p[i] = *(const f32x4*)(rowss + (((size_t)(row >> 8) * 4 + fq) * 256 + (row & 255)) * 4); }
#pragma unroll
    for (int i = 0; i < 8; ++i) { float s = (p[i][0] + p[i][1]) + (p[i][2] + p[i][3]); s += xshfl_f(s, ln ^ 16); s += xshfl_f(s, ln ^ 32); rv[i] = rsqrtf(s * (1.0f / 1024.0f) + 1e-6f); }
}
#define LDS_FENCE() asm volatile("s_waitcnt lgkmcnt(0)" ::: "memory")

constexpr int BM = 256, BK = 64, HALF = 128, HTB = HALF * BK * 2, NXCD = 8, WGM = 8;
__device__ __forceinline__ int lds_byte(int r, int c) { const int st = (r >> 4) * 2 + (c >> 5), rr = r & 15, cc = c & 31, ob = rr * 64 + cc * 2; return st * 1024 + (ob ^ (((ob >> 9) & 1) << 5)); }
__device__ __forceinline__ void stage_rc(int b, int& R, int& C) { const int st = b / 1024, sb = b % 1024, swz = sb ^ (((sb >> 9) & 1) << 5); R = (st >> 1) * 16 + swz / 64; C = (st & 1) * 32 + (swz % 64) / 2; }
__device__ __forceinline__ int perm32(int rho) { const int n = rho >> 4, i = rho & 15; return 8 * (i >> 2) + 4 * n + (i & 3); }

struct Unit { const char* A; const char* B; int pm, pn, kind; };

struct TileOrder {
    int nM, nN, nwg, G, c;
    __device__ void init(int M, int N, int G_, int c_) { nM = M / BM; nN = N / BM; nwg = nM * nN; G = G_; c = c_; }
    __device__ bool tile(int i, int& pm, int& pn) const {
        const long L = (long)i * G + c; if (L >= nwg) return false;
        int wgid = (int)L; { const int q = nwg / NXCD, r = nwg % NXCD, xcd = wgid % NXCD, off = wgid / NXCD; wgid = (xcd < r ? xcd * (q + 1) : r * (q + 1) + (xcd - r) * q) + off; }
        const int nig = WGM * nN, gid = wgid / nig, fm = gid * WGM, gsz = (nM - fm) < WGM ? (nM - fm) : WGM;
        pm = fm + ((wgid % nig) % gsz); pn = (wgid % nig) / gsz; return true;
    }
};
struct PlainOrder {
    TileOrder to; const char* A; const char* B; size_t tstep;
    __device__ bool next(int i, Unit& u) const { int pm, pn; if (!to.tile(i, pm, pn)) return false; u.pm = pm; u.pn = pn; u.kind = 0; u.A = A + (size_t)pm * tstep; u.B = B + (size_t)pn * tstep; return true; }
};
struct Out3Order {
    TileOrder to; const char* xb; const char* wing; const char* inb; const char* inc; const char* wout;
    __device__ bool next(int i, Unit& u) const {
        const int ti = i / 6, sub = i - ti * 6, b = sub >> 1; int pm, pn; if (!to.tile(ti, pm, pn)) return false;
        const size_t tstep = (size_t)256 * 1024 * 2; u.pm = pm; u.pn = pn;
        if ((sub & 1) == 0) { u.kind = 0; u.A = xb + (size_t)pm * tstep; u.B = wing + (size_t)(b * 4 + pn) * tstep; }
        else { u.kind = 1 + b; u.A = (b < 2 ? inb + (size_t)(b * 64 + pm) * tstep : inc + (size_t)pm * tstep); u.B = wout + (size_t)(b * 4 + pn) * tstep; }
        return true;
    }
};

template <class Epi, class Sched>
__device__ __forceinline__ void gemm_phase(const int wv, LAS unsigned char* lds, const int K, const Sched& S_, const Epi& E) {
    const int tid = GET_TID(wv);
    const int wid = __builtin_amdgcn_readfirstlane(tid >> 6), lane = tid & 63, wr = wid >> 2, wc = wid & 3, fr = lane & 15, fq = lane >> 4;
    const int nt = K / BK;
    unsigned voffA[2], voffB[2];
#pragma unroll
    for (int i = 0; i < 2; ++i) { int R, C; stage_rc(tid * 16 + i * 8192, R, C); const int Rb = Epi::PERM ? ((R & ~31) + perm32(R & 31)) : R;
        voffA[i] = (unsigned)(R * K + C) * 2u; voffB[i] = (unsigned)(Rb * K + C) * 2u; }
    const size_t kstep = (size_t)(BK * 2);
    const size_t hstep = (size_t)HALF * K * 2;
    const unsigned ldsw = (unsigned)wid * 1024u;
    const int aoff = lds_byte(wr * 64 + fr, fq * 8), boff = lds_byte(wc * 32 + fr, fq * 8);
#define G_SA(b, h) (((b) * 2 + (h)) * HTB)
#define G_SB(b, h) ((4 + (b) * 2 + (h)) * HTB)
#define G_STAGE(bufoff, gbase, voff) do { _Pragma("unroll") for (int _i = 0; _i < 2; ++_i) \
        __builtin_amdgcn_global_load_lds((const unsigned*)((const char*)(gbase) + (voff)[_i]), (LAS unsigned*)(lds + (bufoff) + ldsw + _i * 8192), 16, 0, 0); } while (0)
#define G_LDA(dst, b, h) do { _Pragma("unroll") for (int m = 0; m < 4; ++m) _Pragma("unroll") for (int k = 0; k < 2; ++k) dst[m][k] = *(const LAS bf16x8*)(lds + G_SA(b, h) + aoff + m * 2048 + k * 1024); } while (0)
#define G_LDB(dst, b, h) do { _Pragma("unroll") for (int n = 0; n < 2; ++n) _Pragma("unroll") for (int k = 0; k < 2; ++k) dst[n][k] = *(const LAS bf16x8*)(lds + G_SB(b, h) + boff + n * 2048 + k * 1024); } while (0)
#define G_MMA(ai, bj, At, Bt) do { __builtin_amdgcn_s_setprio(1); _Pragma("unroll") for (int m = 0; m < 4; ++m) _Pragma("unroll") for (int n = 0; n < 2; ++n) _Pragma("unroll") for (int k = 0; k < 2; ++k) \
        acc[ai][bj][m][n] = __builtin_amdgcn_mfma_f32_16x16x32_bf16(Bt[n][k], At[m][k], acc[ai][bj][m][n], 0, 0, 0); __builtin_amdgcn_s_setprio(0); } while (0)
#define G_WAIT_V(n) asm volatile("s_waitcnt vmcnt(" #n ")" ::: "memory")
#define G_WAIT_L(n) asm volatile("s_waitcnt lgkmcnt(" #n ")" ::: "memory")
#define G_BAR __builtin_amdgcn_s_barrier()
#define G_SCHED __builtin_amdgcn_sched_barrier(0)
    Unit cur, nxt; int ui = 0;
    if (!S_.next(0, cur)) return;
    f32x4 acc[2][2][4][2];
#pragma unroll
    for (int a = 0; a < 2; ++a)
#pragma unroll
        for (int b = 0; b < 2; ++b)
#pragma unroll
            for (int m = 0; m < 4; ++m)
#pragma unroll
                for (int n = 0; n < 2; ++n) acc[a][b][m][n] = (f32x4){0.f, 0.f, 0.f, 0.f};
    bf16x8 At[4][2], B0[2][2], B1[2][2];
    const char* cA = cur.A; const char* cB = cur.B;
    G_STAGE(G_SB(0, 0), cB, voffB); G_STAGE(G_SA(0, 0), cA, voffA); G_STAGE(G_SB(0, 1), cB + hstep, voffB); G_STAGE(G_SA(0, 1), cA + hstep, voffA);
    if (wr == 1) G_BAR;
    G_WAIT_V(4); G_BAR;
    G_STAGE(G_SB(1, 0), cB + kstep, voffB); G_STAGE(G_SA(1, 0), cA + kstep, voffA); G_STAGE(G_SB(1, 1), cB + hstep + kstep, voffB);
    G_WAIT_V(6); G_BAR;
    for (;;) {
        const bool has_next = S_.next(ui + 1, nxt);
        const char* nA = has_next ? nxt.A : cA; const char* nB = has_next ? nxt.B : cB;
        for (int t = 0; t < nt; t += 2) {
            const bool last = (t == nt - 2);
            const char* a1 = cA + (size_t)(t + 1) * kstep;
            const char* a2 = last ? nA : cA + (size_t)(t + 2) * kstep; const char* b2 = last ? nB : cB + (size_t)(t + 2) * kstep;
            const char* a3 = a2 + kstep; const char* b3 = b2 + kstep;
            G_LDB(B0, 0, 0); G_SCHED; G_LDA(At, 0, 0); G_STAGE(G_SA(1, 1), a1 + hstep, voffA);
            G_WAIT_L(8); G_BAR; G_WAIT_L(0); G_MMA(0, 0, At, B0); G_BAR; G_SCHED;
            G_LDB(B1, 0, 1); G_STAGE(G_SB(0, 0), b2, voffB);
            G_BAR; G_WAIT_L(0); G_MMA(0, 1, At, B1); G_BAR;
            G_LDA(At, 0, 1); G_STAGE(G_SA(0, 0), a2, voffA);
            G_BAR; G_WAIT_L(0); G_MMA(1, 0, At, B0); G_BAR; G_SCHED;
            G_STAGE(G_SB(0, 1), b2 + hstep, voffB);
            G_WAIT_V(6); G_BAR; G_MMA(1, 1, At, B1); G_BAR;
            G_LDB(B0, 1, 0); G_SCHED; G_LDA(At, 1, 0); G_STAGE(G_SA(0, 1), a2 + hstep, voffA);
            G_WAIT_L(8); G_BAR; G_WAIT_L(0); G_MMA(0, 0, At, B0); G_BAR; G_SCHED;
            G_LDB(B1, 1, 1); G_STAGE(G_SB(1, 0), b3, voffB);
            G_BAR; G_WAIT_L(0); G_MMA(0, 1, At, B1); G_BAR;
            G_LDA(At, 1, 1); G_STAGE(G_SA(1, 0), a3, voffA);
            G_BAR; G_WAIT_L(0); G_MMA(1, 0, At, B0); G_BAR; G_SCHED;
            G_STAGE(G_SB(1, 1), b3 + hstep, voffB);
            G_WAIT_V(6); G_BAR; G_MMA(1, 1, At, B1); G_BAR;
        }
        E(acc, cur, wr, wc, fr, fq);
        if (!has_next) break;
#pragma unroll
        for (int a = 0; a < 2; ++a)
#pragma unroll
            for (int b = 0; b < 2; ++b)
#pragma unroll
                for (int m = 0; m < 4; ++m)
#pragma unroll
                    for (int n = 0; n < 2; ++n) acc[a][b][m][n] = (f32x4){0.f, 0.f, 0.f, 0.f};
        cur = nxt; cA = nA; cB = nB; ++ui;
    }
    G_WAIT_V(0);
    if (wr == 0) G_BAR;
    G_BAR;
}

typedef f32x4 Acc[2][2][4][2];

struct EpiFfnUp {
    static constexpr bool PERM = true;
    bf16_t* H; const float* rowss;
    __device__ __forceinline__ void operator()(const Acc& acc, const Unit& u, int wr, int wc, int fr, int fq) const {
        int row0 = u.pm * BM + wr * 64 + fr; asm volatile("" : "+v"(row0)); const int col0 = u.pn * 128 + wc * 32 + 8 * fq;
        float rv[8]; load_rinv8(rowss, row0, fq, fq * 16 + fr, rv);
#pragma unroll
        for (int ai = 0; ai < 2; ++ai)
#pragma unroll
            for (int m = 0; m < 4; ++m) {
                const int row = row0 + ai * HALF + m * 16; const float r = rv[ai * 4 + m];
                float o[8];
#pragma unroll
                for (int n = 0; n < 2; ++n)
#pragma unroll
                    for (int j = 0; j < 4; ++j) o[n * 4 + j] = silu_f(acc[ai][0][m][n][j] * r) * (acc[ai][1][m][n][j] * r);
                u32x4 pk = {pk_bf16(o[0], o[1]), pk_bf16(o[2], o[3]), pk_bf16(o[4], o[5]), pk_bf16(o[6], o[7])};
                *(u32x4*)(H + (size_t)row * DFF + col0) = pk;
            }
    }
};

struct EpiResid {
    static constexpr bool PERM = false;
    const float* xin; float* xout; bf16_t* xb; float* rowss_next; float scale;
    __device__ __forceinline__ void operator()(const Acc& acc, const Unit& u, int wr, int wc, int fr, int fq) const {
        int row0 = u.pm * BM + wr * 64 + fr; asm volatile("" : "+v"(row0)); const int col0 = u.pn * BM + wc * 32 + 4 * fq; const int ln = fq * 16 + fr;
#pragma unroll
        for (int ai = 0; ai < 2; ++ai) {
            f32x4 xo[4][2][2];
#pragma unroll
            for (int m = 0; m < 4; ++m)
#pragma unroll
                for (int bj = 0; bj < 2; ++bj)
#pragma unroll
                    for (int n = 0; n < 2; ++n) xo[m][bj][n] = *(const f32x4*)(xin + (size_t)(row0 + ai * HALF + m * 16) * DM + col0 + bj * HALF + n * 16);
#pragma unroll
            for (int m = 0; m < 4; ++m) { const int row = row0 + ai * HALF + m * 16; float ss = 0.f;
#pragma unroll
                for (int bj = 0; bj < 2; ++bj)
#pragma unroll
                    for (int n = 0; n < 2; ++n) { const size_t o = (size_t)row * DM + col0 + bj * HALF + n * 16;
                        const f32x4 v = xo[m][bj][n] + acc[ai][bj][m][n] * scale;
                        *(f32x4*)(xout + o) = v; ss += v[0] * v[0] + v[1] * v[1] + v[2] * v[2] + v[3] * v[3];
                        *(u32x2*)(xb + o) = (u32x2){pk_bf16(v[0], v[1]), pk_bf16(v[2], v[3])}; }
                ss += xshfl_f(ss, ln ^ 16); ss += xshfl_f(ss, ln ^ 32);
                if (fq == 0) rowss_next[(((size_t)(row >> 8) * 4 + u.pn) * 256 + (row & 255)) * 4 + wc] = ss; }
        }
    }
};

struct EpiWin {
    static constexpr bool PERM = false;
    const float* rowss; unsigned char* ws;
    __device__ __forceinline__ void operator()(const Acc& acc, const Unit& u, int wr, int wc, int fr, int fq) const {
        const int pn = u.pn; int row0 = u.pm * BM + wr * 64 + fr; asm volatile("" : "+v"(row0)); const int ctl = wc * 32 + 4 * fq;
        float rv[8]; load_rinv8(rowss, row0, fq, fq * 16 + fr, rv);
        bf16_t* const RNNX = (bf16_t*)(ws + OFF_RNNX); bf16_t* const INB = (bf16_t*)(ws + OFF_INB); bf16_t* const CCH = (bf16_t*)(ws + OFF_CCH);
        bf16_t* const KB = (bf16_t*)(ws + OFF_KB); bf16_t* const VB = (bf16_t*)(ws + OFF_VB); bf16_t* const QI = (bf16_t*)(ws + OFF_QI); bf16_t* const KI = (bf16_t*)(ws + OFF_KI);
        float* const WI = (float*)(ws + OFF_WI);
        const float* const CS128 = (const float*)(ws + OFF_CS128); const float* const CS64 = (const float*)(ws + OFF_CS64);
#pragma unroll
        for (int ai = 0; ai < 2; ++ai)
#pragma unroll
            for (int m = 0; m < 4; ++m) {
                const int row = row0 + ai * HALF + m * 16; const float r = rv[ai * 4 + m];
                if (pn >= 12 && pn < 20) {
#pragma unroll
                    for (int n = 0; n < 2; ++n) { const f32x4 a = acc[ai][0][m][n] * r, b = acc[ai][1][m][n] * r; const f32x4 v = a * b;
                        *(u32x2*)(CCH + (size_t)row * 1024 + (pn - 12) * 128 + ctl + 16 * n) = (u32x2){pk_bf16(v[0], v[1]), pk_bf16(v[2], v[3])}; }
                } else {
#pragma unroll
                    for (int bj = 0; bj < 2; ++bj) {
                        f32x4 v0 = acc[ai][bj][m][0] * r, v1 = acc[ai][bj][m][1] * r; const int ct = bj * HALF + ctl;
                        bf16_t* dst = nullptr;
                        if (pn < 4) dst = RNNX + (size_t)row * 1024 + pn * 256 + ct;
                        else if (pn < 8) { dst = INB + (size_t)row * 1024 + (pn - 4) * 256 + ct;
#pragma unroll
                            for (int j = 0; j < 4; ++j) { v0[j] = gelu_tanh_f(v0[j]); v1[j] = gelu_tanh_f(v1[j]); } }
                        else if (pn < 12) dst = INB + (size_t)T * 1024 + (size_t)row * 1024 + (pn - 8) * 256 + ct;
                        else if (pn < 25) {
                            if (wc == 0) { const f32x4* cs = (const f32x4*)(CS128 + (size_t)row * 32 + 8 * fq);
                                const f32x4 c01 = cs[0], c23 = cs[1]; const float cv[4] = {c01[0], c01[2], c23[0], c23[2]}, sv[4] = {c01[1], c01[3], c23[1], c23[3]};
#pragma unroll
                                for (int j = 0; j < 4; ++j) { const float x1 = v0[j], x2 = v1[j]; v0[j] = x1 * cv[j] - x2 * sv[j]; v1[j] = x2 * cv[j] + x1 * sv[j]; } }
                            if (pn < 24) { v0 *= 0.08838834764831845f; v1 *= 0.08838834764831845f; dst = (bf16_t*)(ws + OFF_Q) + (size_t)row * 1024 + (pn - 20) * 256 + ct; }
                            else dst = KB + (size_t)row * 256 + ct;
                        }
                        else if (pn == 25) dst = VB + (size_t)row * 256 + ct;
                        else if (pn < 28 || (bj == 0 && wc < 2)) {
                            if ((wc & 1) == 0 && fq < 2) { const f32x4* cs = (const f32x4*)(CS64 + (size_t)row * 16 + 8 * fq);
                                const f32x4 c01 = cs[0], c23 = cs[1]; const float cv[4] = {c01[0], c01[2], c23[0], c23[2]}, sv[4] = {c01[1], c01[3], c23[1], c23[3]};
#pragma unroll
                                for (int j = 0; j < 4; ++j) { const float x1 = v0[j], x2 = v1[j]; v0[j] = x1 * cv[j] - x2 * sv[j]; v1[j] = x2 * cv[j] + x1 * sv[j]; } }
                            dst = (pn < 28) ? QI + (size_t)row * 512 + (pn - 26) * 256 + ct : nullptr;
                            if (pn == 28) {
                                bf16_t* kd = KI + ((size_t)(row >> 4) * 8) * 128 + (row & 15) * 8;
                                *(u32x2*)(kd + (ct >> 3) * 128 + (ct & 7)) = (u32x2){pk_bf16(v0[0], v0[1]), pk_bf16(v0[2], v0[3])};
                                *(u32x2*)(kd + ((ct + 16) >> 3) * 128 + ((ct + 16) & 7)) = (u32x2){pk_bf16(v1[0], v1[1]), pk_bf16(v1[2], v1[3])}; }
                        }
                        else if (bj == 0 && wc == 2 && fq < 2) *(f32x4*)(WI + (size_t)row * 8 + 4 * fq) = v0;
                        if (dst) { *(u32x2*)dst = (u32x2){pk_bf16(v0[0], v0[1]), pk_bf16(v0[2], v0[3])}; *(u32x2*)(dst + 16) = (u32x2){pk_bf16(v1[0], v1[1]), pk_bf16(v1[2], v1[3])}; }
                    }
                }
            }
    }
};

struct EpiOut3 {
    static constexpr bool PERM = true;
    const float* rowss; bf16_t* G; float* M;
    __device__ __forceinline__ void operator()(const Acc& acc, const Unit& u, int wr, int wc, int fr, int fq) const {
        int row0 = u.pm * BM + wr * 64 + fr; asm volatile("" : "+v"(row0)); const int col0 = u.pn * BM + wc * 32 + 8 * fq; const int kind = u.kind;
#pragma unroll
        for (int ai = 0; ai < 2; ++ai)
#pragma unroll
            for (int m = 0; m < 4; ++m) {
                const int row = row0 + ai * HALF + m * 16;
                if (kind == 0) { const float r = rinv_of(rowss, row);
#pragma unroll
                    for (int bj = 0; bj < 2; ++bj) { const f32x4 a = acc[ai][bj][m][0] * r, b = acc[ai][bj][m][1] * r;
                        u32x4 pk = {pk_bf16(sigmoid_f(a[0]), sigmoid_f(a[1])), pk_bf16(sigmoid_f(a[2]), sigmoid_f(a[3])), pk_bf16(sigmoid_f(b[0]), sigmoid_f(b[1])), pk_bf16(sigmoid_f(b[2]), sigmoid_f(b[3]))};
                        *(u32x4*)(G + (size_t)row * DM + col0 + bj * HALF) = pk; }
                } else {
#pragma unroll
                    for (int bj = 0; bj < 2; ++bj) { const size_t o = (size_t)row * DM + col0 + bj * HALF;
                        const u32x4 g = *(const u32x4*)(G + o);
                        f32x4 a = acc[ai][bj][m][0], b = acc[ai][bj][m][1];
                        a[0] *= bf_lo(g[0]); a[1] *= bf_hi(g[0]); a[2] *= bf_lo(g[1]); a[3] *= bf_hi(g[1]);
                        b[0] *= bf_lo(g[2]); b[1] *= bf_hi(g[2]); b[2] *= bf_lo(g[3]); b[3] *= bf_hi(g[3]);
                        if (kind > 1) { a += *(const f32x4*)(M + o); b += *(const f32x4*)(M + o + 4); }
                        if (kind < 3) { *(f32x4*)(M + o) = a; *(f32x4*)(M + o + 4) = b; }
                        else { u32x4 pk = {pk_bf16(a[0], a[1]), pk_bf16(a[2], a[3]), pk_bf16(b[0], b[1]), pk_bf16(b[2], b[3])}; *(u32x4*)(G + o) = pk; }
                    }
                }
            }
    }
};

__device__ __forceinline__ int map_col(int kind, int c) {
    if (kind == 0) return c;
    if (kind == 1) { const int pn = c >> 8, bj = (c >> 7) & 1, i = c & 127; return (bj ? 2816 : 0) + pn * 128 + i; }
    if (c < 3072) return c;
    if (c < 5120) { const int cc = c - 3072, tt = cc >> 8, bj = (cc >> 7) & 1, i = cc & 127; return (bj ? 4096 : 3072) + tt * 128 + i; }
    if (c < 6656) return c;
    if (c < 7232) { const int cc = c - 6656, hd = cc >> 6, p = cc & 63; const int d = (p >= 8 && p < 16) ? p + 8 : ((p >= 16 && p < 24) ? p - 8 : p); return 6656 + hd * 64 + d; }
    if (c < 7240) return c;
    if (c < 7424) return -1;
    return 7240 + (c - 7424);
}
struct Job { const float* src; bf16_t* dst; const float* gain; int K, Nsrc, Nlog, kind; };
__device__ __forceinline__ Job get_job(const P& p, int l, int j) {
    Job jb; unsigned char* ws = p.ws;
    switch (j) {
    case 0: jb = {p.ffn1_gu + (size_t)l * 1024 * 5632, (bf16_t*)(ws + OFF_WGU1), p.ffn1_norm + l * 1024, 1024, 5632, 5632, 1}; break;
    case 1: jb = {p.ffn1_dn + (size_t)l * 2816 * 1024, (bf16_t*)(ws + OFF_WD1), nullptr, 2816, 1024, 1024, 0}; break;
    case 2: jb = {p.w_in + (size_t)l * 1024 * 10312, (bf16_t*)(ws + OFF_WIN), p.mix_norm + l * 1024, 1024, 10312, 10496, 2}; break;
    case 3: jb = {p.rnn_w_out + (size_t)l * 1024 * 1024, (bf16_t*)(ws + OFF_WOUT3), nullptr, 1024, 1024, 1024, 0}; break;
    case 4: jb = {p.sconv_w_out + (size_t)l * 1024 * 1024, (bf16_t*)(ws + OFF_WOUT3 + (size_t)2 * 1024 * 1024), nullptr, 1024, 1024, 1024, 0}; break;
    case 5: jb = {p.attn_w_out + (size_t)l * 1024 * 1024, (bf16_t*)(ws + OFF_WOUT3 + (size_t)4 * 1024 * 1024), nullptr, 1024, 1024, 1024, 0}; break;
    case 6: jb = {p.w_o + (size_t)l * 1024 * 1024, (bf16_t*)(ws + OFF_WO), nullptr, 1024, 1024, 1024, 0}; break;
    case 7: jb = {p.ffn2_gu + (size_t)l * 1024 * 5632, (bf16_t*)(ws + OFF_WGU2), p.ffn2_norm + l * 1024, 1024, 5632, 5632, 1}; break;
    default: jb = {p.ffn2_dn + (size_t)l * 2816 * 1024, (bf16_t*)(ws + OFF_WD2), nullptr, 2816, 1024, 1024, 0}; break;
    }
    return jb;
}

__device__ __forceinline__ void prep_phase(const int wv, const P& p, int l, unsigned char* sm, const unsigned jobmask, const int wrank, const int wcount, const bool extras) {
    const int tid = GET_TID(wv); const int lane = tid & 63;
    bf16_t* tl = (bf16_t*)sm;
    int ntile[9]; int total = 0;
#pragma unroll
    for (int j = 0; j < 9; ++j) { const Job jb = get_job(p, l, j); ntile[j] = ((jobmask >> j) & 1u) ? (jb.Nlog / 64) * (jb.K / 64) : 0; total += ntile[j]; }
    for (int tix = wrank; tix < total; tix += 2 * wcount) {
        const int cl = tid & 63, kr = tid >> 6;
        Job jbs[2]; int c0s[2], k0s[2]; float v[2][8]; bool ok[2];
#pragma unroll
        for (int h = 0; h < 2; ++h) { const int tt = tix + h * wcount; ok[h] = tt < total; int jj = 0, rem = ok[h] ? tt : tix;
#pragma unroll
            for (int q = 0; q < 8; ++q) { if (jj == q && rem >= ntile[q]) { rem -= ntile[q]; jj = q + 1; } }
            jbs[h] = get_job(p, l, jj); const int nct = jbs[h].Nlog / 64; c0s[h] = 64 * (rem % nct); k0s[h] = 64 * (rem / nct);
            const int s = map_col(jbs[h].kind, c0s[h] + cl);
#pragma unroll
            for (int i = 0; i < 8; ++i) { const int k = k0s[h] + 8 * kr + i; v[h][i] = (s >= 0) ? jbs[h].src[(size_t)k * jbs[h].Nsrc + s] : 0.f; }
            if (jbs[h].gain) {
#pragma unroll
                for (int i = 0; i < 8; ++i) v[h][i] *= jbs[h].gain[k0s[h] + 8 * kr + i]; } }
#pragma unroll
        for (int h = 0; h < 2; ++h) *(u32x4*)(tl + h * 64 * 72 + cl * 72 + 8 * kr) = (u32x4){pk_bf16(v[h][0], v[h][1]), pk_bf16(v[h][2], v[h][3]), pk_bf16(v[h][4], v[h][5]), pk_bf16(v[h][6], v[h][7])};
        __syncthreads();
#pragma unroll
        for (int h = 0; h < 2; ++h) if (ok[h]) { const int rw = tid >> 3, kk = (tid & 7) * 8; const u32x4 d = *(const u32x4*)(tl + h * 64 * 72 + rw * 72 + kk);
            *(u32x4*)(jbs[h].dst + (size_t)(c0s[h] + rw) * jbs[h].K + k0s[h] + kk) = d; }
        __syncthreads();
    }
    if (extras) { bf16_t* wrg = (bf16_t*)(p.ws + OFF_WRG); const float* wa = p.ga_w + (size_t)l * 16 * 64 * 64; const float* wx = p.gx_w + (size_t)l * 16 * 64 * 64;
      for (int e = blockIdx.x * 512 + tid; e < 16 * 128 * 64; e += gridDim.x * 512) { const int i = e & 63, jp = (e >> 6) & 127, n = e >> 13;
          const float v = (jp < 64 ? wa : wx)[(size_t)n * 4096 + i * 64 + (jp & 63)]; wrg[e] = f2bf(v); } }
    if (extras && l == 0) {
        float* rowss = (float*)(p.ws + OFF_ROWSS);
        bf16_t* xb = (bf16_t*)(p.ws + OFF_XB);
        for (int row = blockIdx.x * 8 + (tid >> 6); row < T; row += gridDim.x * 8) { float ss = 0.f;
#pragma unroll
            for (int i = 0; i < 4; ++i) { const size_t o = (size_t)row * DM + 4 * lane + 256 * i; const f32x4 v = *(const f32x4*)(p.x + o);
                ss += v[0] * v[0] + v[1] * v[1] + v[2] * v[2] + v[3] * v[3]; *(u32x2*)(xb + o) = (u32x2){pk_bf16(v[0], v[1]), pk_bf16(v[2], v[3])}; }
#pragma unroll
            for (int d = 32; d >= 1; d >>= 1) ss += xshfl_f(ss, lane ^ d);
            if (lane < 16) rowss[(((size_t)(row >> 8) * 4 + (lane >> 2)) * 256 + (row & 255)) * 4 + (lane & 3)] = (lane == 0) ? ss : 0.f; }
        float* cs128 = (float*)(p.ws + OFF_CS128); float* cs64 = (float*)(p.ws + OFF_CS64);
        for (int t = blockIdx.x * 512 + tid; t < T; t += gridDim.x * 512) { const double posd = (double)p.pos[t];
#pragma unroll 1
            for (int i = 0; i < 24; ++i) {
                const float ex = (i < 16) ? (float)i * (1.0f / 16.0f) : (float)(i - 16) * (1.0f / 8.0f);
                const float inv_freq = exp2f(-ex * 18.931568569324174f);
                const double ang = posd * (double)inv_freq; const double rev = ang * 0.15915494309189535; const float fr = (float)(rev - floor(rev));
                const float sn = __builtin_amdgcn_sinf(fr), cs = __builtin_amdgcn_cosf(fr);
                float* d = (i < 16) ? cs128 + (size_t)t * 32 + 2 * i : cs64 + (size_t)t * 16 + 2 * (i - 16); d[0] = cs; d[1] = sn; } }
    }
}

__device__ __forceinline__ void rnn_phase(const int wv, const P& p, int l, unsigned char* sm, const bool final) {
    const int tid = GET_TID(wv); const int lane = tid & 63, wid = tid >> 6, fq = lane >> 4, fr = lane & 15;
    bf16_t* WGs = (bf16_t*)sm;
    bf16_t* XAb = (bf16_t*)(sm + 18432);
    float* XAf = (float*)(sm + 27648);
    float* GT = (float*)(sm + 44032);
    float* SEGP = (float*)(sm + 77824);
    float* SEGH = (float*)(sm + 79872);
    float* CAR = (float*)(sm + 81920);
    const bf16_t* RNNX = (const bf16_t*)(p.ws + OFF_RNNX); bf16_t* INA = (bf16_t*)(p.ws + OFF_INB);
    const bf16_t* WRG = (const bf16_t*)(p.ws + OFF_WRG);
    float* RSP = (float*)(p.ws + OFF_RS); float* RSH = RSP + (size_t)NB * NCH * 1024;
    const float* convw = p.rnn_conv_w + (size_t)l * 4 * 1024; const float* convb = p.rnn_conv_b + l * 1024;
    const float* gab = p.ga_b + l * 1024; const float* gxb = p.gx_b + l * 1024; const float* lam = p.lam + l * 1024;
    for (int tix = blockIdx.x; tix < NB * 16 * NCH; tix += gridDim.x) {
        const int n = tix & 15, b = (tix >> 4) & 3, ch = tix >> 6;
#pragma unroll
        for (int q = 0; q < 2; ++q) { const int ck = tid + 512 * q, jp = ck >> 3, i8 = (ck & 7) * 8;
            *(u32x4*)(WGs + jp * 72 + i8) = *(const u32x4*)(WRG + (size_t)n * 8192 + jp * 64 + i8); }
        const int c = tid & 63, seg = tid >> 6;
        const float sp = log1pf(__expf(-lam[64 * n + c]));
        if (tid < 64) { float hc = 0.f;
            if (final) { for (int cc = 0; cc < ch; ++cc) { const size_t o = ((size_t)(b * NCH + cc)) * 1024 + 64 * n + c; hc = RSP[o] * hc + RSH[o]; } }
            CAR[c] = hc; }
        float PC = 1.0f, hlast = 0.f;
        const int ctok = tid >> 3, cc8 = (tid & 7) * 8, ccb = 64 * n + cc8;
        f32x4 cw[4][2], cbv[2]; float gbias[4];
        cbv[0] = *(const f32x4*)(convb + ccb); cbv[1] = *(const f32x4*)(convb + ccb + 4);
#pragma unroll
        for (int k = 0; k < 4; ++k) { cw[k][0] = *(const f32x4*)(convw + k * 1024 + ccb); cw[k][1] = *(const f32x4*)(convw + k * 1024 + ccb + 4); }
#pragma unroll
        for (int q = 0; q < 4; ++q) { const int jp = 16 * (4 * (wid >> 2) + q) + fr; gbias[q] = (jp < 64) ? gab[64 * n + jp] : gxb[64 * n + jp - 64]; }
        u32x4 raw[4];
#define RNN_LOADX(sub_) do { _Pragma("unroll") for (int k = 0; k < 4; ++k) { const int tt = ch * LC + (sub_) * 64 + ctok - 3 + k; \
            raw[k] = (tt >= 0) ? *(const u32x4*)(RNNX + ((size_t)b * S + tt) * 1024 + ccb) : (u32x4){0u, 0u, 0u, 0u}; } } while (0)
        RNN_LOADX(0);
        for (int sub = 0; sub < LC / 64; ++sub) {
            const int t0 = ch * LC + sub * 64; const size_t g0 = (size_t)b * S + t0;
            {
                const int tok = ctok, c8 = cc8; const int cb = ccb;
                float xa[8];
                { const f32x4 b0 = cbv[0], b1 = cbv[1];
                  xa[0] = b0[0]; xa[1] = b0[1]; xa[2] = b0[2]; xa[3] = b0[3]; xa[4] = b1[0]; xa[5] = b1[1]; xa[6] = b1[2]; xa[7] = b1[3]; }
#pragma unroll
                for (int k = 0; k < 4; ++k) {
                        const f32x4 w0 = cw[k][0], w1 = cw[k][1];
                        xa[0] += w0[0] * bf_lo(raw[k][0]); xa[1] += w0[1] * bf_hi(raw[k][0]); xa[2] += w0[2] * bf_lo(raw[k][1]); xa[3] += w0[3] * bf_hi(raw[k][1]);
                        xa[4] += w1[0] * bf_lo(raw[k][2]); xa[5] += w1[1] * bf_hi(raw[k][2]); xa[6] += w1[2] * bf_lo(raw[k][3]); xa[7] += w1[3] * bf_hi(raw[k][3]); }
                *(f32x4*)(XAf + tok * 64 + c8) = (f32x4){xa[0], xa[1], xa[2], xa[3]}; *(f32x4*)(XAf + tok * 64 + c8 + 4) = (f32x4){xa[4], xa[5], xa[6], xa[7]};
                *(u32x4*)(XAb + tok * 72 + c8) = (u32x4){pk_bf16(xa[0], xa[1]), pk_bf16(xa[2], xa[3]), pk_bf16(xa[4], xa[5]), pk_bf16(xa[6], xa[7])};
                if (sub + 1 < LC / 64) RNN_LOADX(sub + 1);
            }
            __syncthreads();
            {
                const int mt = wid & 3;
                const bf16x8 a0 = *(const bf16x8*)(XAb + (16 * mt + fr) * 72 + 8 * fq), a1 = *(const bf16x8*)(XAb + (16 * mt + fr) * 72 + 32 + 8 * fq);
#pragma unroll
                for (int q = 0; q < 4; ++q) { const int ct = 4 * (wid >> 2) + q;
                    const bf16x8 b0 = *(const bf16x8*)(WGs + (16 * ct + fr) * 72 + 8 * fq), b1 = *(const bf16x8*)(WGs + (16 * ct + fr) * 72 + 32 + 8 * fq);
                    f32x4 cacc = {0.f, 0.f, 0.f, 0.f};
                    cacc = __builtin_amdgcn_mfma_f32_16x16x32_bf16(a0, b0, cacc, 0, 0, 0); cacc = __builtin_amdgcn_mfma_f32_16x16x32_bf16(a1, b1, cacc, 0, 0, 0);
                    const int jp = 16 * ct + fr; const float bias = gbias[q];
#pragma unroll
                    for (int r = 0; r < 4; ++r) GT[(16 * mt + 4 * fq + r) * 132 + jp] = sigmoid_f(cacc[r] + bias); }
            }
            __syncthreads();
            unsigned short gv[8];
            if (final) {
#pragma unroll
                for (int k = 0; k < 8; ++k) gv[k] = INA[(g0 + 8 * seg + k) * 1024 + 64 * n + c]; }
            else {
#pragma unroll
                for (int k = 0; k < 8; ++k) gv[k] = 0; }
            float hl[8], pc[8]; float hh = 0.f, pp = 1.0f;
#pragma unroll
            for (int k = 0; k < 8; ++k) { const int tok = 8 * seg + k; const float rg = GT[tok * 132 + c], ig = GT[tok * 132 + 64 + c], xv = XAf[tok * 64 + c];
                const float loga = -8.0f * rg * sp; const float a = __expf(loga); const float x2 = 2.0f * loga;
                const float om = (x2 > -0.25f) ? -x2 * (1.0f + 0.5f * x2 * (1.0f + (1.0f / 3.0f) * x2 * (1.0f + 0.25f * x2 * (1.0f + 0.2f * x2 * (1.0f + (1.0f / 6.0f) * x2))))) : 1.0f - __expf(x2);
                const float sc = __builtin_amdgcn_sqrtf(fmaxf(om, 0.f));
                const float uu = sc * (ig * xv); hh = a * hh + uu; pp *= a; hl[k] = hh; pc[k] = pp; }
            SEGP[seg * 64 + c] = pp; SEGH[seg * 64 + c] = hh;
            __syncthreads();
            float hc = CAR[(sub & 1) * 64 + c];
            for (int s2 = 0; s2 < seg; ++s2) hc = SEGP[s2 * 64 + c] * hc + SEGH[s2 * 64 + c];
            if (final) {
#pragma unroll
                for (int k = 0; k < 8; ++k) { const size_t o = (g0 + 8 * seg + k) * 1024 + 64 * n + c; const float hv = hl[k] + pc[k] * hc;
                    INA[o] = f2bf(hv * bf_lo((unsigned)gv[k])); }
            }
            if (seg == 7) { hlast = hl[7] + pc[7] * hc; CAR[((sub + 1) & 1) * 64 + c] = hlast;
                float pt = 1.0f;
#pragma unroll
                for (int s2 = 0; s2 < 8; ++s2) pt *= SEGP[s2 * 64 + c];
                PC *= pt; }
        }
        __syncthreads();
        if (!final && seg == 7) { const size_t o = ((size_t)(b * NCH + ch)) * 1024 + 64 * n + c; RSP[o] = PC; RSH[o] = hlast; }
    }
}

__device__ __forceinline__ void sconv_phase(const int wv, const P& p, int l) {
    const bf16_t* CCH = (const bf16_t*)(p.ws + OFF_CCH); bf16_t* INBB = (bf16_t*)(p.ws + OFF_INB + (size_t)T * 1024 * 2);
    const float* w = p.sconv_w + (size_t)l * 3 * 1024;
    const int tid = GET_TID(wv);
    for (int e = blockIdx.x * 512 + tid; e < T * 128; e += gridDim.x * 512) {
        const int t = e >> 7, c8 = (e & 127) * 8; const int tt = t & (S - 1);
        float a[8] = {0.f, 0.f, 0.f, 0.f, 0.f, 0.f, 0.f, 0.f};
#pragma unroll
        for (int k = 0; k < 3; ++k) { if (tt - 2 + k >= 0) { const u32x4 raw = *(const u32x4*)(CCH + (size_t)(t - 2 + k) * 1024 + c8);
                const f32x4 w0 = *(const f32x4*)(w + k * 1024 + c8), w1 = *(const f32x4*)(w + k * 1024 + c8 + 4);
                a[0] += w0[0] * bf_lo(raw[0]); a[1] += w0[1] * bf_hi(raw[0]); a[2] += w0[2] * bf_lo(raw[1]); a[3] += w0[3] * bf_hi(raw[1]);
                a[4] += w1[0] * bf_lo(raw[2]); a[5] += w1[1] * bf_hi(raw[2]); a[6] += w1[2] * bf_lo(raw[3]); a[7] += w1[3] * bf_hi(raw[3]); } }
        const u32x4 cb = *(const u32x4*)(INBB + (size_t)t * 1024 + c8);
        const u32x4 o = {pk_bf16(a[0] * bf_lo(cb[0]), a[1] * bf_hi(cb[0])), pk_bf16(a[2] * bf_lo(cb[1]), a[3] * bf_hi(cb[1])),
                         pk_bf16(a[4] * bf_lo(cb[2]), a[5] * bf_hi(cb[2])), pk_bf16(a[6] * bf_lo(cb[3]), a[7] * bf_hi(cb[3]))};
        *(u32x4*)(INBB + (size_t)t * 1024 + c8) = o;
    }
}

__device__ __forceinline__ unsigned mono_key(float f) { unsigned u = __float_as_uint(f); if (u == 0x80000000u) u = 0u; return (u & 0x80000000u) ? ~u : (u | 0x80000000u); }

__device__ __forceinline__ void att_phase(const int wv, const P& p, unsigned char* sm) {
    const int tid = GET_TID(wv); const int lane = tid & 63, wid = tid >> 6, fq = lane >> 4, fr = lane & 15;
    float* SC = (float*)sm;
    LAS unsigned* HIST = (LAS unsigned*)(LAS unsigned char*)(sm + 131072);
    unsigned* IDX = (unsigned*)(sm + 131072 + 8192);
    const bf16_t* QI = (const bf16_t*)(p.ws + OFF_QI); const bf16_t* KI = (const bf16_t*)(p.ws + OFF_KI); const float* WI = (const float*)(p.ws + OFF_WI);
    const bf16_t* Q = (const bf16_t*)(p.ws + OFF_Q); bf16_t* AO = (bf16_t*)(p.ws + OFF_CCH); const bf16_t* KB = (const bf16_t*)(p.ws + OFF_KB); const bf16_t* VB = (const bf16_t*)(p.ws + OFF_VB);
    const unsigned long long ltmask = (1ull << lane) - 1ull;
    *(LAS u32x4*)(HIST + 4 * tid) = (u32x4){0u, 0u, 0u, 0u};
    __syncthreads();
    for (int tix = blockIdx.x; tix < NB * (S / 8); tix += gridDim.x) {
        const int id = NB * (S / 8) - 1 - tix; const int b = id & 3, qg = id >> 2, t0 = qg * 8; const size_t gt0 = (size_t)b * S + t0;
        {
            bf16x8 qa[4][2]; f32x4 wv[4];
#pragma unroll
            for (int mt = 0; mt < 4; ++mt) { const int ql = 2 * mt + (fr >> 3), hd = fr & 7;
#pragma unroll
                for (int ks = 0; ks < 2; ++ks) qa[mt][ks] = *(const bf16x8*)(QI + (gt0 + ql) * 512 + hd * 64 + 32 * ks + 8 * fq);
                wv[mt] = *(const f32x4*)(WI + (gt0 + 2 * mt + (fq >> 1)) * 8 + 4 * (fq & 1)); }
            const int nkt = (t0 + 8 + 15) >> 4;
            const bf16_t* kibase = KI + (size_t)b * S * 64 + (fq * 16 + fr) * 8;
            bf16x8 nb0, nb1; { const int kb = min(wid, S / 16 - 1); nb0 = *(const bf16x8*)(kibase + (size_t)kb * 1024); nb1 = *(const bf16x8*)(kibase + (size_t)kb * 1024 + 512); }
            for (int kt = wid; kt < nkt; kt += 8) { const int key = 16 * kt + fr;
                const bf16x8 kb0 = nb0, kb1 = nb1;
                { const int kb = min(kt + 8, S / 16 - 1); nb0 = *(const bf16x8*)(kibase + (size_t)kb * 1024); nb1 = *(const bf16x8*)(kibase + (size_t)kb * 1024 + 512); }
#pragma unroll
                for (int mp = 0; mp < 2; ++mp) {
                    float part[2];
#pragma unroll
                    for (int hh = 0; hh < 2; ++hh) { const int mt = 2 * mp + hh; f32x4 cacc = {0.f, 0.f, 0.f, 0.f};
                        cacc = __builtin_amdgcn_mfma_f32_16x16x32_bf16(qa[mt][0], kb0, cacc, 0, 0, 0); cacc = __builtin_amdgcn_mfma_f32_16x16x32_bf16(qa[mt][1], kb1, cacc, 0, 0, 0);
                        part[hh] = wv[mt][0] * fmaxf(cacc[0], 0.f) + wv[mt][1] * fmaxf(cacc[1], 0.f) + wv[mt][2] * fmaxf(cacc[2], 0.f) + wv[mt][3] * fmaxf(cacc[3], 0.f); }
                    const bool odd = (fq & 1) != 0;
                    const float recv = xshfl_f(odd ? part[0] : part[1], lane ^ 16);
                    const float tot = odd ? (recv + part[1]) : (part[0] + recv);
                    const int ql = 2 * (2 * mp + (odd ? 1 : 0)) + (fq >> 1); const unsigned kbits = mono_key(tot);
                    SC[ql * 4096 + key] = __uint_as_float(kbits);
                    if (key <= t0 + ql) __hip_atomic_fetch_add(HIST + ql * 256 + (kbits >> 24), 1u, __ATOMIC_RELAXED, __HIP_MEMORY_SCOPE_WORKGROUP); } }
        }
        __syncthreads();
        {
            const int t = t0 + wid, n = t + 1; const size_t gt = gt0 + wid;
            float* sc = SC + wid * 4096; LAS unsigned* hist = HIST + wid * 256; unsigned* idx = IDX + wid * 256;
            int nsel;
            if (n <= 256) { for (int i = lane; i < 256; i += 64) idx[i] = (i < n) ? (unsigned)i : 0u; nsel = n; }
            else {
                unsigned prefix = 0u, remaining = 256u;
#define SEL_FIND_BIN() do { LDS_FENCE(); const u32x4 h4 = *(const LAS u32x4*)(hist + 4 * lane); \
        const unsigned s_ = h4[0] + h4[1] + h4[2] + h4[3]; unsigned suf = s_; \
        _Pragma("unroll") for (int d = 1; d < 64; d <<= 1) { const unsigned v = xshfl_u(suf, (lane + d) & 63); if (lane + d < 64) suf += v; } \
        const unsigned long long mask = __ballot(suf >= remaining); const int L = 63 - __clzll(mask); \
        unsigned cum = suf - s_; int bsel; \
        if (cum + h4[3] >= remaining) bsel = 3; else { cum += h4[3]; if (cum + h4[2] >= remaining) bsel = 2; else { cum += h4[2]; if (cum + h4[1] >= remaining) bsel = 1; else { cum += h4[1]; bsel = 0; } } } \
        bsel = (int)xshfl_u((unsigned)bsel, L); cum = xshfl_u(cum, L); \
        remaining -= cum; binsel = (unsigned)(4 * L + bsel); } while (0)
                unsigned binsel;
                SEL_FIND_BIN(); prefix = binsel;
                {   const int shift = 16;
                    *(LAS u32x4*)(hist + 4 * lane) = (u32x4){0u, 0u, 0u, 0u};
                    LDS_FENCE();
                    for (int i0 = lane; i0 < n; i0 += 512) { float sv[8];
#pragma unroll
                        for (int q = 0; q < 8; ++q) sv[q] = sc[min(i0 + 64 * q, 4095)];
#pragma unroll
                        for (int q = 0; q < 8; ++q) { const unsigned k = __float_as_uint(sv[q]);
                            if (i0 + 64 * q < n && (k >> 24) == prefix) __hip_atomic_fetch_add(hist + ((k >> shift) & 255u), 1u, __ATOMIC_RELAXED, __HIP_MEMORY_SCOPE_WORKGROUP); } }
                    SEL_FIND_BIN(); prefix = (prefix << 8) | binsel; }
                unsigned base = 0u, C = 0u;
                for (int i0 = 0; i0 < n; i0 += 512) { float sv[8];
#pragma unroll
                    for (int q = 0; q < 8; ++q) sv[q] = sc[min(i0 + 64 * q + lane, 4095)];
                    LDS_FENCE();
#pragma unroll
                    for (int q = 0; q < 8; ++q) { const int i = i0 + 64 * q + lane; const bool valid = i < n; const unsigned k = valid ? __float_as_uint(sv[q]) : 0u;
                        const bool gtr = valid && (k >> 16) > prefix, eq = valid && (k >> 16) == prefix;
                        const unsigned long long smk = __ballot(gtr); const unsigned pos = base + (unsigned)__popcll(smk & ltmask);
                        if (gtr && pos < 256u) idx[pos] = (unsigned)i; base += (unsigned)__popcll(smk);
                        const unsigned long long em = __ballot(eq); const unsigned cpos = C + (unsigned)__popcll(em & ltmask);
                        if (eq) sc[cpos] = __uint_as_float(((k & 0xffffu) << 12) | (unsigned)i); C += (unsigned)__popcll(em); } }
                unsigned lp = 0u;
                for (int pass = 0; pass < 2; ++pass) { const int shift = 8 - 8 * pass;
                    *(LAS u32x4*)(hist + 4 * lane) = (u32x4){0u, 0u, 0u, 0u};
                    LDS_FENCE();
                    for (unsigned j = lane; j < C; j += 64) { const unsigned low = __float_as_uint(sc[j]) >> 12;
                        if (pass == 0 || (low >> 8) == lp) __hip_atomic_fetch_add(hist + ((low >> shift) & 255u), 1u, __ATOMIC_RELAXED, __HIP_MEMORY_SCOPE_WORKGROUP); }
                    SEL_FIND_BIN(); lp = (lp << 8) | binsel; }
                unsigned eqbase = 0u;
                for (unsigned j0 = 0; j0 < C; j0 += 64) { const unsigned j = j0 + lane; const bool valid = j < C; const unsigned w = valid ? __float_as_uint(sc[j]) : 0u;
                    const unsigned low = w >> 12; const bool gtr = valid && low > lp, eq = valid && low == lp;
                    const unsigned long long em = __ballot(eq); const unsigned er = eqbase + (unsigned)__popcll(em & ltmask);
                    const bool sel = gtr || (eq && er < remaining);
                    const unsigned long long smk = __ballot(sel); const unsigned pos = base + (unsigned)__popcll(smk & ltmask);
                    if (sel && pos < 256u) idx[pos] = w & 4095u; base += (unsigned)__popcll(smk); eqbase += (unsigned)__popcll(em); }
#undef SEL_FIND_BIN
                nsel = 256;
            }
            LDS_FENCE();
            bf16x8 qf[2][4];
#pragma unroll
            for (int g = 0; g < 2; ++g)
#pragma unroll
                for (int ks = 0; ks < 4; ++ks) qf[g][ks] = *(const bf16x8*)(Q + gt * 1024 + (4 * g + (fr & 3)) * 128 + 32 * ks + 8 * fq);
            float* P1 = sc; float* P2 = sc + 2048; bf16_t* Pb = (bf16_t*)(sc + 2048);
            const int nkt2 = (nsel + 15) >> 4;
            {
                const bf16_t* kbase = KB + (size_t)b * S * 256 + 8 * (lane & 31);
                unsigned char* stage = (unsigned char*)(sc + 2048);
                const int hrow = lane >> 5, chunk = lane & 31;
                bf16x8 kc[8], kn[8];
#define QK_LOAD(dst, kt_) do { _Pragma("unroll") for (int q_ = 0; q_ < 8; ++q_) { const unsigned kx_ = idx[16 * (kt_) + 2 * q_ + hrow]; \
        dst[q_] = *(const bf16x8*)(kbase + (size_t)kx_ * 256); } } while (0)
#define QK_MMA(srcv, kt_) do { LDS_FENCE(); \
        _Pragma("unroll") for (int q_ = 0; q_ < 8; ++q_) { const int r_ = 2 * q_ + hrow; *(bf16x8*)(stage + r_ * 512 + ((chunk & 16) | ((chunk ^ r_) & 15)) * 16) = srcv[q_]; } \
        LDS_FENCE(); \
        __builtin_amdgcn_s_setprio(1); \
        _Pragma("unroll") for (int g = 0; g < 2; ++g) { f32x4 cacc = {0.f, 0.f, 0.f, 0.f}; \
        _Pragma("unroll") for (int ks = 0; ks < 4; ++ks) { const int c_ = g * 16 + ks * 4 + fq; \
            const bf16x8 af = *(const bf16x8*)(stage + fr * 512 + ((c_ & 16) | ((c_ ^ fr) & 15)) * 16); \
            cacc = __builtin_amdgcn_mfma_f32_16x16x32_bf16(af, qf[g][ks], cacc, 0, 0, 0); } \
        if (fr < 4) { _Pragma("unroll") for (int r = 0; r < 4; ++r) P1[(4 * g + fr) * 256 + 16 * (kt_) + 4 * fq + r] = cacc[r]; } } __builtin_amdgcn_s_setprio(0); } while (0)
                QK_LOAD(kc, 0);
                for (int kt = 0; kt < nkt2; kt += 2) {
                    QK_LOAD(kn, min(kt + 1, 15));
                    QK_MMA(kc, kt);
                    QK_LOAD(kc, min(kt + 2, 15));
                    if (kt + 1 < nkt2) QK_MMA(kn, kt + 1);
                }
#undef QK_LOAD
#undef QK_MMA
            }
            LDS_FENCE();
#pragma unroll
            for (int h = 0; h < 8; ++h) { float v[4]; float mx = -3.0e38f;
#pragma unroll
                for (int jj = 0; jj < 4; ++jj) { const int sl = lane + 64 * jj; v[jj] = (sl < nsel) ? P1[h * 256 + sl] : -3.0e38f; mx = fmaxf(mx, v[jj]); }
#pragma unroll
                for (int d = 32; d >= 1; d >>= 1) mx = fmaxf(mx, xshfl_f(mx, lane ^ d));
                float e[4], sum = 0.f;
#pragma unroll
                for (int jj = 0; jj < 4; ++jj) { const int sl = lane + 64 * jj; e[jj] = (sl < nsel) ? __expf(v[jj] - mx) : 0.f; sum += e[jj]; }
#pragma unroll
                for (int d = 32; d >= 1; d >>= 1) sum += xshfl_f(sum, lane ^ d);
                const float inv = 1.0f / sum;
#pragma unroll
                for (int jj = 0; jj < 4; ++jj) Pb[h * 264 + lane + 64 * jj] = f2bf(e[jj] * inv); }
            LDS_FENCE();
            {
                unsigned char* vst = (unsigned char*)sc;
                const bf16_t* vbase = VB + (size_t)b * S * 256 + 8 * (lane & 15);
                const int srow = lane >> 4;
                f32x4 oacc[2][8];
#pragma unroll
                for (int g = 0; g < 2; ++g)
#pragma unroll
                    for (int dt = 0; dt < 8; ++dt) oacc[g][dt] = (f32x4){0.f, 0.f, 0.f, 0.f};
                const int nstep = (nsel + 31) >> 5;
                bf16x8 vc[8], vn[8];
#define PV_LOAD(dst, st_, g_) do { _Pragma("unroll") for (int i_ = 0; i_ < 8; ++i_) { const unsigned kx_ = idx[32 * (st_) + 4 * i_ + srow]; \
        dst[i_] = *(const bf16x8*)(vbase + (size_t)kx_ * 256 + (g_) * 128); } } while (0)
#define PV_MMA(srcv, st_, g_) do { LDS_FENCE(); \
        _Pragma("unroll") for (int i_ = 0; i_ < 8; ++i_) { const int rw_ = 4 * i_ + srow; *(bf16x8*)(vst + rw_ * 256 + (((lane & 15) ^ (((rw_ & 3) << 2) | ((rw_ >> 2) & 3))) * 16)) = srcv[i_]; } \
        LDS_FENCE(); \
        const bf16x8 af = *(const bf16x8*)(Pb + ((g_) * 4 + (fr & 3)) * 264 + 32 * (st_) + 8 * fq); __builtin_amdgcn_s_setprio(1); \
        _Pragma("unroll") for (int dt = 0; dt < 8; ++dt) { \
            const int r0_ = 8 * fq + (fr >> 2), r1_ = r0_ + 4, ch_ = 2 * dt + ((fr & 3) >> 1); \
            const LAS s16x4* ta_ = (const LAS s16x4*)(LAS unsigned char*)(vst + r0_ * 256 + ((ch_ ^ (((r0_ & 3) << 2) | ((r0_ >> 2) & 3))) * 16) + (fr & 1) * 8); \
            const LAS s16x4* tb_ = (const LAS s16x4*)(LAS unsigned char*)(vst + r1_ * 256 + ((ch_ ^ (((r1_ & 3) << 2) | ((r1_ >> 2) & 3))) * 16) + (fr & 1) * 8); \
            const s16x4 t0_ = __builtin_amdgcn_ds_read_tr16_b64_v4i16((LAS s16x4*)ta_), t1_ = __builtin_amdgcn_ds_read_tr16_b64_v4i16((LAS s16x4*)tb_); \
            const bf16x8 bfv = __builtin_shufflevector(t0_, t1_, 0, 1, 2, 3, 4, 5, 6, 7); \
            oacc[g_][dt] = __builtin_amdgcn_mfma_f32_16x16x32_bf16(af, bfv, oacc[g_][dt], 0, 0, 0); } __builtin_amdgcn_s_setprio(0); } while (0)
                PV_LOAD(vc, 0, 0);
                for (int st = 0; st < nstep; ++st) {
                    PV_LOAD(vn, st, 1);
                    PV_MMA(vc, st, 0);
                    PV_LOAD(vc, min(st + 1, 7), 0);
                    PV_MMA(vn, st, 1);
                }
#undef PV_LOAD
#undef PV_MMA
                if (fq == 0) {
#pragma unroll
                    for (int g = 0; g < 2; ++g)
#pragma unroll
                        for (int dt = 0; dt < 8; ++dt)
#pragma unroll
                            for (int r = 0; r < 4; ++r) AO[gt * 1024 + (4 * g + r) * 128 + 16 * dt + fr] = f2bf(oacc[g][dt][r]);
                }
            }
            LDS_FENCE(); *(LAS u32x4*)(hist + 4 * lane) = (u32x4){0u, 0u, 0u, 0u};
        }
        __syncthreads();
    }
}

__device__ __forceinline__ void gsync(cg::grid_group& grid) {
    asm volatile("s_waitcnt vmcnt(0) lgkmcnt(0)" ::: "memory");
    grid.sync();
    if (__builtin_amdgcn_readfirstlane(threadIdx.x >> 6) == 0) { __builtin_amdgcn_fence(__ATOMIC_ACQUIRE, "agent"); asm volatile("s_waitcnt vmcnt(0) lgkmcnt(0)" ::: "memory"); }
    __syncthreads();
}

#define XB_TMO      128
#define XB_XCNT(j)  (256  + 64 * (j))
#define XB_XSUB(j)  (1280 + 64 * (j))
#define XB_XGEN(j)  (2304 + 64 * (j))
#define XB_TOP      3328
#define XB_TOPGEN   3392
#define XCD_BAR_WORDS 3456
#define XB_SPIN_CAP (1u << 18)
__device__ __forceinline__ unsigned xb_ld(unsigned* p)              { return __hip_atomic_load(p, __ATOMIC_RELAXED, __HIP_MEMORY_SCOPE_AGENT); }
__device__ __forceinline__ unsigned xb_add(unsigned* p, unsigned v) { return __hip_atomic_fetch_add(p, v, __ATOMIC_RELAXED, __HIP_MEMORY_SCOPE_AGENT); }
__device__ __forceinline__ unsigned xb_xcc_id() { return (unsigned)__builtin_amdgcn_s_getreg((3 << 11) | 20) & 0xFu; }
#define XB_SPIN(cond, bar) do { unsigned _sp = 0; while (cond) { __builtin_amdgcn_s_sleep(1); \
    if ((++_sp & 255u) == 0u) { if (xb_ld(&(bar)[XB_TMO])) break; if (_sp > XB_SPIN_CAP) { atomicAdd(&(bar)[XB_TMO], 1u); break; } } } } while (0)
__device__ __forceinline__ void xcd_barrier_complete(unsigned* bar, unsigned x, unsigned& nloc, unsigned& nx) {
    const unsigned G = gridDim.x * gridDim.y * gridDim.z;
    unsigned sum, cnt, mine, sp = 0u;
    for (;;) {
        sum = 0u; cnt = 0u; mine = 0u;
#pragma unroll
        for (unsigned j = 0; j < 16; ++j) { const unsigned c = xb_ld(&bar[XB_XCNT(j)]); sum += c; cnt += (c > 0u) ? 1u : 0u; mine = (j == x) ? c : mine; }
        if (sum == G) break;
        __builtin_amdgcn_s_sleep(1);
        if ((++sp & 255u) == 0u) { if (xb_ld(&bar[XB_TMO])) break; if (sp > XB_SPIN_CAP) { atomicAdd(&bar[XB_TMO], 1u); break; } }
    }
    nloc = mine > 0u ? mine : 1u; nx = cnt > 0u ? cnt : 1u;
}
__device__ __forceinline__ void xsync(unsigned* bar, volatile LAS unsigned* st) {
    asm volatile("s_waitcnt vmcnt(0) lgkmcnt(0)" ::: "memory");
    __syncthreads();
    if (threadIdx.x == 0) {
        const unsigned x = xb_xcc_id();
        __builtin_amdgcn_s_waitcnt(0);
        unsigned nloc = st[0], nx = st[1];
        if (nloc == 0u) { xcd_barrier_complete(bar, x, nloc, nx); st[0] = nloc; st[1] = nx; }
        const unsigned old = xb_add(&bar[XB_XSUB(x)], 1u);
        const unsigned gen = old / nloc;
        if (old + 1u == (gen + 1u) * nloc) {
            __builtin_amdgcn_fence(__ATOMIC_RELEASE, "agent");
            asm volatile("s_waitcnt vmcnt(0)" ::: "memory");
            const unsigned og = xb_add(&bar[XB_TOP], 1u);
            const unsigned tg = og / nx;
            if (og + 1u == (tg + 1u) * nx) xb_add(&bar[XB_TOPGEN], 1u);
            else XB_SPIN(xb_ld(&bar[XB_TOPGEN]) == tg, bar);
            __builtin_amdgcn_fence(__ATOMIC_ACQUIRE, "agent");
            xb_add(&bar[XB_XGEN(x)], 1u);
            asm volatile("s_waitcnt vmcnt(0)" ::: "memory");
        } else {
            XB_SPIN(xb_ld(&bar[XB_XGEN(x)]) == gen, bar);
            __builtin_amdgcn_fence(__ATOMIC_ACQUIRE, "agent");
            asm volatile("s_waitcnt vmcnt(0)" ::: "memory");
        }
    }
    __syncthreads();
}

#define CAS __attribute__((address_space(4)))
#if defined(__HIP_DEVICE_COMPILE__)
#define LOADP_COPY(dst, srcp) __builtin_memcpy(&(dst), (srcp), sizeof(P))
#else
#define LOADP_COPY(dst, srcp) ((void)(srcp))
#endif
#define LOADP() P pl; { const CAS P* q_ = (const CAS P*)__builtin_amdgcn_kernarg_segment_ptr(); asm volatile("" : "+s"(q_)); LOADP_COPY(pl, q_); } \
    unsigned char* const ws = pl.ws; float* const rowss = (float*)(ws + OFF_ROWSS); const int G = gridDim.x, c = blockIdx.x; (void)rowss; (void)G; (void)c;
__global__ void __launch_bounds__(512, 2) mk_forward(P p_unused) {
    cg::grid_group grid = cg::this_grid();
    extern __shared__ __attribute__((aligned(16))) unsigned char shm[];
    LAS unsigned char* lds = (LAS unsigned char*)shm;
    const int wv = __builtin_amdgcn_readfirstlane(threadIdx.x >> 6);
    volatile LAS unsigned* xst = (volatile LAS unsigned*)(lds + 147456);
    if (threadIdx.x == 0) { xst[0] = 0u; xst[1] = 0u; xst[2] = 0u; xst[3] = 0u; }
    __syncthreads();
    { LOADP(); if (threadIdx.x == 0) (void)xb_add(&((unsigned*)(ws + OFF_BAR))[XB_XCNT(xb_xcc_id())], 1u); }
    { LOADP(); if (pl.out == nullptr) gsync(grid); }
#define XSYNC() do { LOADP(); xsync((unsigned*)(ws + OFF_BAR), xst); } while (0)
    for (int l = 0; l < 2; ++l) {
        { LOADP(); prep_phase(wv, pl, l, shm, (l == 1 && G == 256) ? 0x183u : 0x1FFu, c, G, true); }
        XSYNC();
        for (int f = 0; f < 2; ++f) {
            if (f == 1) {
                { LOADP(); PlainOrder so; so.to.init(T, 7424, G, c); so.A = (const char*)(ws + OFF_XB); so.B = (const char*)(ws + OFF_WIN); so.tstep = (size_t)256 * 1024 * 2;
                  EpiWin e; e.rowss = rowss + (size_t)(3 * l + 1) * T * 16; e.ws = ws; gemm_phase(wv, lds, 1024, so, e); }
                XSYNC();
                { LOADP(); rnn_phase(wv, pl, l, shm, false); }
                { LOADP(); sconv_phase(wv, pl, l); }
                XSYNC();
                { LOADP(); rnn_phase(wv, pl, l, shm, true); }
                { LOADP(); att_phase(wv, pl, shm); }
                XSYNC();
                { LOADP(); Out3Order so; so.to.init(T, 1024, G, c); so.xb = (const char*)(ws + OFF_XB); so.wing = (const char*)(ws + OFF_WIN + (size_t)7424 * 1024 * 2);
                  so.inb = (const char*)(ws + OFF_INB); so.inc = (const char*)(ws + OFF_CCH); so.wout = (const char*)(ws + OFF_WOUT3);
                  EpiOut3 e; e.rowss = rowss + (size_t)(3 * l + 1) * T * 16; e.G = (bf16_t*)(ws + OFF_RNNX); e.M = (float*)(ws + OFF_Q); gemm_phase(wv, lds, 1024, so, e); }
                XSYNC();
                { LOADP(); PlainOrder so; so.to.init(T, 1024, G, c); so.A = (const char*)(ws + OFF_RNNX); so.B = (const char*)(ws + OFF_WO); so.tstep = (size_t)256 * 1024 * 2;
                  EpiResid e; e.xin = pl.out; e.xout = pl.out; e.xb = (bf16_t*)(ws + OFF_XB); e.rowss_next = rowss + (size_t)(3 * l + 2) * T * 16; e.scale = 1.0f; gemm_phase(wv, lds, 1024, so, e); }
                XSYNC();
            }
            { LOADP(); PlainOrder so; so.to.init(T, 5632, G, c); so.A = (const char*)(ws + OFF_XB); so.B = (const char*)(ws + (f ? OFF_WGU2 : OFF_WGU1)); so.tstep = (size_t)256 * 1024 * 2;
              EpiFfnUp e; e.H = (bf16_t*)(ws + OFF_H); e.rowss = rowss + (size_t)(3 * l + 2 * f) * T * 16; gemm_phase(wv, lds, 1024, so, e); }
            if (l == 0 && f == 1 && gridDim.x == 256 && (int)blockIdx.x >= 128) { LOADP(); prep_phase(wv, pl, 1, shm, 0x07Cu, c - 128, 128, false); }
            XSYNC();
            { LOADP(); PlainOrder so; so.to.init(T, 1024, G, c); so.A = (const char*)(ws + OFF_H); so.B = (const char*)(ws + (f ? OFF_WD2 : OFF_WD1)); so.tstep = (size_t)256 * 2816 * 2;
              EpiResid e; e.xin = (l == 0 && f == 0) ? pl.x : pl.out; e.xout = pl.out; e.xb = (bf16_t*)(ws + OFF_XB); e.rowss_next = rowss + (size_t)(3 * l + 2 * f + 1) * T * 16; e.scale = 0.5f; gemm_phase(wv, lds, 2816, so, e); }
            XSYNC();
        }
    }
    { LOADP(); const float* rs = rowss + (size_t)6 * T * 16;
      const int tid = GET_TID(wv);
      const int lane = tid & 63; f32x4 gn[4];
#pragma unroll
      for (int i = 0; i < 4; ++i) gn[i] = *(const f32x4*)(pl.final_norm + 4 * lane + 256 * i);
      for (int row = blockIdx.x * 8 + (tid >> 6); row < T; row += gridDim.x * 8) { const float r = rinv_of(rs, row);
#pragma unroll
          for (int i = 0; i < 4; ++i) { const size_t o = (size_t)row * DM + 4 * lane + 256 * i; f32x4 v = *(const f32x4*)(pl.out + o); v = v * r * gn[i]; *(f32x4*)(pl.out + o) = v; } } }
}

extern "C" void kernel_launch(void* const* d_in, const int* in_sizes, int n_in, void* d_out, int out_size, void* d_ws, size_t ws_size, hipStream_t stream) {
    static int grid_blocks = 0;
    if (!grid_blocks) {
        (void)hipFuncSetAttribute((const void*)mk_forward, hipFuncAttributeMaxDynamicSharedMemorySize, (int)DYN_LDS);
        int dev = 0, cus = 0, per_cu = 0; (void)hipGetDevice(&dev);
        (void)hipDeviceGetAttribute(&cus, hipDeviceAttributeMultiprocessorCount, dev);
        (void)hipOccupancyMaxActiveBlocksPerMultiprocessor(&per_cu, mk_forward, 512, DYN_LDS);
        if (per_cu > 1) per_cu = 1;
        grid_blocks = cus * per_cu;
    }
    if (ws_size < WS_NEED || n_in < 23) return;
    P p{};
    p.x = (const float*)d_in[0]; p.pos = (const int*)d_in[1];
    p.ffn1_norm = (const float*)d_in[2]; p.ffn1_gu = (const float*)d_in[3]; p.ffn1_dn = (const float*)d_in[4]; p.mix_norm = (const float*)d_in[5]; p.w_in = (const float*)d_in[6];
    p.rnn_conv_w = (const float*)d_in[7]; p.rnn_conv_b = (const float*)d_in[8]; p.ga_w = (const float*)d_in[9]; p.ga_b = (const float*)d_in[10]; p.gx_w = (const float*)d_in[11]; p.gx_b = (const float*)d_in[12];
    p.lam = (const float*)d_in[13]; p.rnn_w_out = (const float*)d_in[14]; p.sconv_w = (const float*)d_in[15]; p.sconv_w_out = (const float*)d_in[16]; p.attn_w_out = (const float*)d_in[17]; p.w_o = (const float*)d_in[18];
    p.ffn2_norm = (const float*)d_in[19]; p.ffn2_gu = (const float*)d_in[20]; p.ffn2_dn = (const float*)d_in[21]; p.final_norm = (const float*)d_in[22];
    p.out = (float*)d_out; p.ws = (unsigned char*)d_ws;
    (void)hipMemsetAsync((unsigned char*)d_ws + OFF_BAR, 0, 16384, stream);
    void* args[] = {&p};
    (void)hipLaunchCooperativeKernel((void*)mk_forward, dim3(grid_blocks), dim3(512), args, DYN_LDS, stream);
}
```
